# Optimizing an MI355X kernel written in HIP

```python
import jax, jax.numpy as jnp
from jax import lax
import numpy as np

D_MODEL = 1024
BATCH = 8
SEQ = 4096
DEPTH = 2

N_A_LAYERS = DEPTH // 2
N_B_LAYERS = DEPTH - N_A_LAYERS
HEAD_DIM = 64
MIX_WIDTH = D_MODEL
MEM_HEADS = 4
MEM_WIDTH = MEM_HEADS * HEAD_DIM
N_MEM = 256
LRU_WIDTH = MIX_WIDTH - MEM_WIDTH
LRU_BLOCKS = 6
LRU_BLOCK = LRU_WIDTH // LRU_BLOCKS
CONV_WIDTH = 4
LRU_C = 8.0
SWA_Q_HEADS = (MIX_WIDTH - MEM_WIDTH) // HEAD_DIM
SWA_KV_HEADS = 4
SWA_GROUP = SWA_Q_HEADS // SWA_KV_HEADS
KV_WIDTH = SWA_KV_HEADS * HEAD_DIM
WINDOW = 128
BLOCK = 128
ROPE_DIM = HEAD_DIM // 4
ROPE_THETA = 500000.0
D_FF = -(-8 * D_MODEL // (3 * 256)) * 256
A_IN_WIDTH = 2 * LRU_WIDTH + MEM_WIDTH
B_IN_WIDTH = SWA_Q_HEADS * HEAD_DIM + MEM_WIDTH
EPS = 1e-6
NEG_INF = -1e30

kernel_name = "hybrid_rglru_swa_sink_yoco"


def rms_norm(x, g):
    xf = x.astype(jnp.float32)
    y = xf * lax.rsqrt(jnp.mean(xf * xf, axis=-1, keepdims=True) + EPS)
    return (y * g.astype(jnp.float32)).astype(x.dtype)


def rope_tables(seq):
    inv_freq = 1.0 / (ROPE_THETA ** (jnp.arange(0, ROPE_DIM, 2, dtype=jnp.float32) / ROPE_DIM))
    ang = jnp.arange(seq, dtype=jnp.float32)[:, None] * inv_freq[None, :]
    return jnp.cos(ang), jnp.sin(ang)


def apply_partial_rope(x, cos, sin):
    half = ROPE_DIM // 2
    xr = x[..., :ROPE_DIM].astype(jnp.float32)
    x1, x2 = xr[..., :half], xr[..., half:]
    c = cos[None, :, None, :]
    s = sin[None, :, None, :]
    rot = jnp.concatenate([x1 * c - x2 * s, x2 * c + x1 * s], axis=-1).astype(x.dtype)
    return jnp.concatenate([rot, x[..., ROPE_DIM:]], axis=-1)


def causal_depthwise_conv(x, w, b):
    c = x.shape[-1]
    y = lax.conv_general_dilated(
        x, w[:, None, :].astype(x.dtype), window_strides=(1,),
        padding=[(CONV_WIDTH - 1, 0)], dimension_numbers=("NWC", "WIO", "NWC"),
        feature_group_count=c)
    return y + b


def _linear_recurrence_combine(left, right):
    a1, b1 = left
    a2, b2 = right
    return a1 * a2, a2 * b1 + b2


def rg_lru(x, w_r, b_r, w_i, b_i, lam):
    bsz, seq, width = x.shape
    xb = x.reshape(bsz, seq, LRU_BLOCKS, LRU_BLOCK)
    r = jax.nn.sigmoid(jnp.einsum("bshi,hij->bshj", xb, w_r)
                       + b_r.reshape(LRU_BLOCKS, LRU_BLOCK)).reshape(bsz, seq, width)
    i = jax.nn.sigmoid(jnp.einsum("bshi,hij->bshj", xb, w_i)
                       + b_i.reshape(LRU_BLOCKS, LRU_BLOCK)).reshape(bsz, seq, width)
    log_a = LRU_C * r.astype(jnp.float32) * jax.nn.log_sigmoid(lam.astype(jnp.float32))
    a = jnp.exp(log_a)
    mult = jnp.sqrt(jnp.maximum(1.0 - jnp.exp(2.0 * log_a), 0.0))
    first = (jnp.arange(seq) == 0)[None, :, None]
    mult = jnp.where(first, 1.0, mult)
    u = mult * (i * x).astype(jnp.float32)
    _, h = lax.associative_scan(_linear_recurrence_combine, (a, u), axis=1)
    return h.astype(x.dtype)


def sliding_window_attention_with_sinks(q, k, v, sinks):
    bsz, seq = q.shape[0], q.shape[1]
    nb = seq // BLOCK
    qb = q.reshape(bsz, nb, BLOCK, SWA_KV_HEADS, SWA_GROUP, HEAD_DIM)

    def band(t):
        cur = t.reshape(bsz, nb, BLOCK, SWA_KV_HEADS, HEAD_DIM)
        prev = jnp.concatenate([jnp.zeros_like(cur[:, :1]), cur[:, :-1]], axis=1)
        return jnp.concatenate([prev, cur], axis=2)

    kb, vb = band(k), band(v)
    scores = jnp.einsum("bnqkgd,bnckd->bnkgqc", qb, kb).astype(jnp.float32) * (HEAD_DIM ** -0.5)
    qi = jnp.arange(BLOCK)[:, None] + BLOCK
    ci = jnp.arange(2 * BLOCK)[None, :]
    rel = qi - ci
    in_window = (rel >= 0) & (rel < WINDOW)
    has_prev = (jnp.arange(nb) > 0)[:, None, None] | (ci >= BLOCK)[None]
    mask = in_window[None] & has_prev
    scores = jnp.where(mask[None, :, None, None], scores, NEG_INF)
    sink = sinks.astype(jnp.float32).reshape(1, 1, SWA_KV_HEADS, SWA_GROUP, 1, 1)
    m = jnp.maximum(jnp.max(scores, axis=-1, keepdims=True), sink)
    e = jnp.exp(scores - m)
    probs = e / (jnp.sum(e, axis=-1, keepdims=True) + jnp.exp(sink - m))
    out = jnp.einsum("bnkgqc,bnckd->bnqkgd", probs.astype(v.dtype), vb)
    return out.reshape(bsz, seq, SWA_Q_HEADS * HEAD_DIM)


def memory_attention(q, mk, mv):
    bsz, seq = q.shape[0], q.shape[1]
    s = jnp.einsum("bshd,bmhd->bhsm", q, mk).astype(jnp.float32) * (HEAD_DIM ** -0.5)
    p = jax.nn.softmax(s, axis=-1).astype(mv.dtype)
    o = jnp.einsum("bhsm,bmhd->bshd", p, mv)
    return o.reshape(bsz, seq, MEM_WIDTH)


def swiglu_ffn(x, w_in, w_out):
    gu = x @ w_in
    g, u = gu[..., :D_FF], gu[..., D_FF:]
    return (jax.nn.silu(g) * u) @ w_out


def setup_inputs(seed: int = 0) -> dict:
    key = jax.random.key(seed)
    ks = jax.random.split(key, 24)

    def nrm(k, shape, scale):
        return jax.random.normal(k, shape, dtype=jnp.float32) * scale

    def gain(k, shape):
        return 1.0 + 0.05 * jax.random.normal(k, shape, dtype=jnp.float32)

    u = jax.random.uniform(ks[14], (N_A_LAYERS, LRU_WIDTH), dtype=jnp.float32,
                           minval=0.81, maxval=0.998)
    a0 = jnp.sqrt(u)
    lru_lambda = jnp.log(a0) - jnp.log1p(-a0)
    return {
        "x": nrm(ks[0], (BATCH, SEQ, D_MODEL), 1.0),
        "mem": nrm(ks[1], (BATCH, N_MEM, D_MODEL), 1.0),
        "norm_mix_pre": gain(ks[2], (DEPTH, D_MODEL)),
        "norm_mix_post": gain(ks[3], (DEPTH, D_MODEL)),
        "norm_ffn_pre": gain(ks[4], (DEPTH, D_MODEL)),
        "norm_ffn_post": gain(ks[5], (DEPTH, D_MODEL)),
        "mem_norm": gain(ks[6], (D_MODEL,)),
        "w_mem_kv": nrm(ks[7], (DEPTH, D_MODEL, 2 * MEM_WIDTH), D_MODEL ** -0.5),
        "w_in_a": nrm(ks[8], (N_A_LAYERS, D_MODEL, A_IN_WIDTH), D_MODEL ** -0.5),
        "conv_w": nrm(ks[9], (N_A_LAYERS, CONV_WIDTH, LRU_WIDTH), CONV_WIDTH ** -0.5),
        "conv_b": nrm(ks[10], (N_A_LAYERS, LRU_WIDTH), 0.02),
        "w_gate_r": nrm(ks[11], (N_A_LAYERS, LRU_BLOCKS, LRU_BLOCK, LRU_BLOCK), LRU_BLOCK ** -0.5),
        "b_gate_r": nrm(ks[12], (N_A_LAYERS, LRU_WIDTH), 0.02),
        "w_gate_i": nrm(ks[13], (N_A_LAYERS, LRU_BLOCKS, LRU_BLOCK, LRU_BLOCK), LRU_BLOCK ** -0.5),
        "b_gate_i": nrm(ks[15], (N_A_LAYERS, LRU_WIDTH), 0.02),
        "lru_lambda": lru_lambda,
        "norm_kv": gain(ks[16], (D_MODEL,)),
        "w_kv_shared": nrm(ks[17], (D_MODEL, 2 * KV_WIDTH), D_MODEL ** -0.5),
        "w_in_b": nrm(ks[18], (N_B_LAYERS, D_MODEL, B_IN_WIDTH), D_MODEL ** -0.5),
        "sinks": nrm(ks[19], (N_B_LAYERS, SWA_Q_HEADS), 1.0),
        "w_out": nrm(ks[20], (DEPTH, MIX_WIDTH, D_MODEL), MIX_WIDTH ** -0.5),
        "w_ffn_in": nrm(ks[21], (DEPTH, D_MODEL, 2 * D_FF), D_MODEL ** -0.5),
        "w_ffn_out": nrm(ks[22], (DEPTH, D_FF, D_MODEL), D_FF ** -0.5),
    }


def reference(x, mem, norm_mix_pre, norm_mix_post, norm_ffn_pre, norm_ffn_post, mem_norm,
              w_mem_kv, w_in_a, conv_w, conv_b, w_gate_r, b_gate_r, w_gate_i, b_gate_i,
              lru_lambda, norm_kv, w_kv_shared, w_in_b, sinks, w_out, w_ffn_in, w_ffn_out):
    bsz, seq = x.shape[0], x.shape[1]
    n_mem = mem.shape[1]
    cos, sin = rope_tables(seq)
    mem_n = rms_norm(mem, mem_norm)
    h = x
    shared_k = None
    shared_v = None
    for l in range(DEPTH):
        hn = rms_norm(h, norm_mix_pre[l])
        mkv = mem_n @ w_mem_kv[l]
        mk = mkv[..., :MEM_WIDTH].reshape(bsz, n_mem, MEM_HEADS, HEAD_DIM)
        mv = mkv[..., MEM_WIDTH:].reshape(bsz, n_mem, MEM_HEADS, HEAD_DIM)
        if l < N_A_LAYERS:
            a = l
            proj = hn @ w_in_a[a]
            xr = proj[..., :LRU_WIDTH]
            gate = proj[..., LRU_WIDTH:2 * LRU_WIDTH]
            mq = proj[..., 2 * LRU_WIDTH:].reshape(bsz, seq, MEM_HEADS, HEAD_DIM)
            xr = causal_depthwise_conv(xr, conv_w[a], conv_b[a])
            y = rg_lru(xr, w_gate_r[a], b_gate_r[a], w_gate_i[a], b_gate_i[a], lru_lambda[a])
            y = y * jax.nn.gelu(gate)
        else:
            b = l - N_A_LAYERS
            proj = hn @ w_in_b[b]
            q = proj[..., :SWA_Q_HEADS * HEAD_DIM].reshape(bsz, seq, SWA_Q_HEADS, HEAD_DIM)
            mq = proj[..., SWA_Q_HEADS * HEAD_DIM:].reshape(bsz, seq, MEM_HEADS, HEAD_DIM)
            q = apply_partial_rope(q, cos, sin)
            y = sliding_window_attention_with_sinks(q, shared_k, shared_v, sinks[b])
        m_out = memory_attention(mq, mk, mv)
        mixed = jnp.concatenate([y, m_out], axis=-1) @ w_out[l]
        h = h + rms_norm(mixed, norm_mix_post[l])
        f = swiglu_ffn(rms_norm(h, norm_ffn_pre[l]), w_ffn_in[l], w_ffn_out[l])
        h = h + rms_norm(f, norm_ffn_post[l])
        if l == N_A_LAYERS - 1:
            kv = rms_norm(h, norm_kv) @ w_kv_shared
            shared_k = apply_partial_rope(
                kv[..., :KV_WIDTH].reshape(bsz, seq, SWA_KV_HEADS, HEAD_DIM), cos, sin)
            shared_v = kv[..., KV_WIDTH:].reshape(bsz, seq, SWA_KV_HEADS, HEAD_DIM)
    return h
```

```cpp
#include <hip/hip_runtime.h>
#include <hip/hip_cooperative_groups.h>
#include <cstdio>
#include <cstdint>
namespace cg = cooperative_groups;

#define LAS __attribute__((address_space(3)))
typedef unsigned short bf16_t;
typedef short bf16x8 __attribute__((ext_vector_type(8)));
typedef short s16x4 __attribute__((ext_vector_type(4)));
typedef float f32x4 __attribute__((ext_vector_type(4)));
typedef float f32x2 __attribute__((ext_vector_type(2)));
typedef float f32x16 __attribute__((ext_vector_type(16)));
typedef unsigned u32x4 __attribute__((ext_vector_type(4)));
typedef unsigned u32x2 __attribute__((ext_vector_type(2)));

#ifndef MK_MULTI
#define MK_MULTI 0
#endif

constexpr int D = 1024, BATCH = 8, SEQ = 4096, T = BATCH * SEQ, NMEM = 256, TM = BATCH * NMEM;
constexpr int LRU_W = 768, MEM_W = 256, DFF = 2816, A_IN = 1792;
constexpr float EPS = 1e-6f;
constexpr float LOG2E = 1.4426950408889634f;
constexpr float QSCALE = 0.125f * LOG2E;

constexpr size_t MiB = 1u << 20;
constexpr size_t al256(size_t x) { return (x + 255) & ~(size_t)255; }
constexpr size_t O_WMKV = 1 * MiB;
constexpr size_t O_WINA = O_WMKV + (size_t)1024 * 1024 * 2;
constexpr size_t O_WG   = O_WINA + (size_t)A_IN * 1024 * 2;
constexpr size_t O_WKVQ = O_WG + (size_t)6 * 256 * 128 * 2;
constexpr size_t O_WOUT = O_WKVQ + (size_t)1536 * 1024 * 2;
constexpr size_t O_WFFI = O_WOUT + (size_t)2 * 1024 * 1024 * 2;
constexpr size_t O_WFFO = O_WFFI + (size_t)2 * 5632 * 1024 * 2;
constexpr size_t O_ROPE = O_WFFO + (size_t)2 * 1024 * DFF * 2;
constexpr size_t O_CLAM = O_ROPE + (size_t)4096 * 16 * 4;
constexpr size_t O_MEMN = al256(O_CLAM + 768 * 4);
constexpr size_t O_MK   = O_MEMN + (size_t)TM * 1024 * 2;
constexpr size_t O_MVT  = O_MK + (size_t)2 * TM * 256 * 2;
constexpr size_t O_RS   = O_MVT + (size_t)2 * TM * 256 * 2;
constexpr size_t O_END_SMALL = O_RS + (size_t)T * 4;
static_assert(O_END_SMALL <= 64 * MiB, "small region");
constexpr size_t O_HN    = 64 * MiB;
constexpr size_t O_MIXED = 128 * MiB;
constexpr size_t O_KS    = 192 * MiB;
constexpr size_t O_VST   = 208 * MiB;
constexpr size_t O_MIX   = 224 * MiB;
constexpr size_t O_XRLA  = O_MIX;
constexpr size_t O_GATES = O_MIX;
constexpr size_t O_XC    = O_MIX + 96 * MiB;
constexpr size_t O_GG    = O_MIX + 144 * MiB;
constexpr size_t O_MQ    = O_MIX + 192 * MiB;
constexpr size_t O_Y     = O_MIX + 208 * MiB;
constexpr size_t O_Q     = O_MIX;
constexpr size_t O_Y1    = O_MIX + 64 * MiB;
constexpr size_t O_HB    = O_HN;
constexpr size_t O_FF    = O_MIX;
constexpr size_t WS_NEED = O_MIX + 272 * MiB;

constexpr int LDS_BYTES = 147456;

__device__ __forceinline__ unsigned cvt_pk_bf16(float lo, float hi) { unsigned r; asm volatile("v_cvt_pk_bf16_f32 %0, %1, %2" : "=v"(r) : "v"(lo), "v"(hi)); return r; }
__device__ __forceinline__ float bf_lo(unsigned w) { return __uint_as_float(w << 16); }
__device__ __forceinline__ float bf_hi(unsigned w) { return __uint_as_float(w & 0xffff0000u); }
__device__ __forceinline__ float ex2(float x) { return __builtin_amdgcn_exp2f(x); }
__device__ __forceinline__ float rcpf_(float x) { return __builtin_amdgcn_rcpf(x); }
__device__ __forceinline__ float sigmoidf_(float x) { return rcpf_(1.f + ex2(-x * LOG2E)); }
__device__ __forceinline__ float gelu_tanh(float x) { const float u = 0.7978845608028654f * (x + 0.044715f * x * x * x); return x * rcpf_(1.f + ex2(-2.f * LOG2E * u)); }
__device__ __forceinline__ float wave_sum(float v) {
#pragma unroll
    for (int o = 1; o < 64; o <<= 1) v += __shfl_xor(v, o);
    return v;
}

namespace pg8 {
constexpr int BM = 256, BK = 64, HALF = 128, HTB = HALF * BK * 2, STAGE_BYTES = 8 * HTB, NXCD = 8, WGM = 8;
__host__ __device__ __forceinline__ int lds_byte(int r, int c) { const int st = (r >> 4) * 2 + (c >> 5), rr = r & 15, cc = c & 31, ob = rr * 64 + cc * 2; return st * 1024 + (ob ^ (((ob >> 9) & 1) << 5)); }
__host__ __device__ __forceinline__ void stage_rc(int b, int& R, int& C) { const int st = b / 1024, sb = b % 1024, swz = sb ^ (((sb >> 9) & 1) << 5); R = (st >> 1) * 16 + swz / 64; C = (st & 1) * 32 + (swz % 64) / 2; }
__host__ __device__ __forceinline__ int perm32(int rho) { const int n = rho >> 4, i = rho & 15; return 8 * (i >> 2) + 4 * n + (i & 3); }

struct Unit { int pm, pn; };
struct Gemm { const bf16_t* A; const bf16_t* Bt; int M, N, K, lda, ldb, a_pn_off; };

struct StaticOrder {
    int nM, nN, nwg, G, c;
    __host__ __device__ void init(int M, int N, int G_, int c_) { nM = M / BM; nN = N / BM; nwg = nM * nN; G = G_; c = c_; }
    __host__ __device__ bool next(int i, Unit& u) const {
        const long L = (long)i * G + c; if (L >= nwg) return false;
        int wgid = (int)L; { const int q = nwg / NXCD, r = nwg % NXCD, xcd = wgid % NXCD, off = wgid / NXCD; wgid = (xcd < r ? xcd * (q + 1) : r * (q + 1) + (xcd - r) * q) + off; }
        const int nig = WGM * nN, gid = wgid / nig, fm = gid * WGM, gsz = (nM - fm) < WGM ? (nM - fm) : WGM;
        u.pm = fm + ((wgid % nig) % gsz); u.pn = (wgid % nig) / gsz; return true;
    }
};

template <class Epi>
__device__ __forceinline__ void gemm_phase(LAS unsigned char* lds, const Gemm g, const StaticOrder& S, const Epi& E) {
    const int tid = threadIdx.x, wid = __builtin_amdgcn_readfirstlane(tid >> 6), lane = tid & 63, wr = wid >> 2, wc = wid & 3, fr = lane & 15, fq = lane >> 4;
    const int K = g.K, nt = K / BK;
    unsigned voffA, voffB;
    { int R, C; stage_rc(tid * 16, R, C); const int Rb = (R & ~31) + perm32(R & 31); voffA = (unsigned)(R * g.lda + C) * 2u; voffB = (unsigned)(Rb * g.ldb + C) * 2u; }
    const unsigned rstepA = 64u * (unsigned)g.lda * 2u, rstepB = 64u * (unsigned)g.ldb * 2u;
    const size_t kstep = (size_t)(BK * 2);
    const size_t hstepA = (size_t)HALF * g.lda * 2, hstepB = (size_t)HALF * g.ldb * 2;
    const size_t tstepA = 2 * hstepA, tstepB = 2 * hstepB;
    const unsigned ldsw = (unsigned)wid * 1024u;
    const int aoff = lds_byte(wr * 64 + fr, fq * 8), boff = lds_byte(wc * 32 + fr, fq * 8);
#define PG8_SA(b, h) (((b) * 2 + (h)) * HTB)
#define PG8_SB(b, h) ((4 + (b) * 2 + (h)) * HTB)
#define PG8_STAGE(bufoff, gbase, voff) do { _Pragma("unroll") for (int _i = 0; _i < 2; ++_i) \
        __builtin_amdgcn_global_load_lds((const unsigned*)((const char*)(gbase) + (size_t)_i * PG8_RSTEP_##voff + voff), (LAS unsigned*)(lds + (bufoff) + ldsw + _i * 8192), 16, 0, 0); } while (0)
#define PG8_RSTEP_voffA rstepA
#define PG8_RSTEP_voffB rstepB
#define PG8_LDA(dst, b, h) do { _Pragma("unroll") for (int m = 0; m < 4; ++m) _Pragma("unroll") for (int k = 0; k < 2; ++k) dst[m][k] = *(const LAS bf16x8*)(lds + PG8_SA(b, h) + aoff + m * 2048 + k * 1024); } while (0)
#define PG8_LDB(dst, b, h) do { _Pragma("unroll") for (int n = 0; n < 2; ++n) _Pragma("unroll") for (int k = 0; k < 2; ++k) dst[n][k] = *(const LAS bf16x8*)(lds + PG8_SB(b, h) + boff + n * 2048 + k * 1024); } while (0)
#define PG8_MMA(ai, bj, At, Bt) do { __builtin_amdgcn_s_setprio(1); _Pragma("unroll") for (int m = 0; m < 4; ++m) _Pragma("unroll") for (int n = 0; n < 2; ++n) _Pragma("unroll") for (int k = 0; k < 2; ++k) \
        acc[ai][bj][m][n] = __builtin_amdgcn_mfma_f32_16x16x32_bf16(Bt[n][k], At[m][k], acc[ai][bj][m][n], 0, 0, 0); __builtin_amdgcn_s_setprio(0); } while (0)
#define PG8_MMA0(ai, bj, At, Bt) do { __builtin_amdgcn_s_setprio(1); _Pragma("unroll") for (int m = 0; m < 4; ++m) _Pragma("unroll") for (int n = 0; n < 2; ++n) { \
        acc[ai][bj][m][n] = __builtin_amdgcn_mfma_f32_16x16x32_bf16(Bt[n][0], At[m][0], (f32x4){0.f, 0.f, 0.f, 0.f}, 0, 0, 0); \
        acc[ai][bj][m][n] = __builtin_amdgcn_mfma_f32_16x16x32_bf16(Bt[n][1], At[m][1], acc[ai][bj][m][n], 0, 0, 0); } __builtin_amdgcn_s_setprio(0); } while (0)
#define PG8_WAIT_V(n) asm volatile("s_waitcnt vmcnt(" #n ")" ::: "memory")
#define PG8_WAIT_L(n) asm volatile("s_waitcnt lgkmcnt(" #n ")" ::: "memory")
#define PG8_BAR __builtin_amdgcn_s_barrier()
#define PG8_SCHED __builtin_amdgcn_sched_barrier(0)
    Unit cur, nxt; int ui = 0;
    if (!S.next(0, cur)) return;
    f32x4 acc[2][2][4][2];
    bf16x8 At[4][2], B0[2][2], B1[2][2];
    const char* cA = (const char*)g.A + (size_t)cur.pm * tstepA + (size_t)cur.pn * g.a_pn_off * 2; const char* cB = (const char*)g.Bt + (size_t)cur.pn * tstepB;
    PG8_STAGE(PG8_SB(0, 0), cB, voffB); PG8_STAGE(PG8_SB(0, 1), cB + hstepB, voffB); PG8_STAGE(PG8_SA(0, 0), cA, voffA); PG8_STAGE(PG8_SA(0, 1), cA + hstepA, voffA);
    if (wr == 1) PG8_BAR;
    PG8_WAIT_V(2); PG8_BAR;
    PG8_STAGE(PG8_SB(1, 0), cB + kstep, voffB); PG8_STAGE(PG8_SA(1, 0), cA + kstep, voffA); PG8_STAGE(PG8_SB(1, 1), cB + hstepB + kstep, voffB);
    PG8_WAIT_V(6); PG8_BAR;
    for (;;) {
        const bool has_next = S.next(ui + 1, nxt);
        const char* nA = has_next ? (const char*)g.A + (size_t)nxt.pm * tstepA + (size_t)nxt.pn * g.a_pn_off * 2 : cA; const char* nB = has_next ? (const char*)g.Bt + (size_t)nxt.pn * tstepB : cB;
        float pre[8]; E.prefetch(pre, cur, wr, fr);
        for (int t = 0; t < nt; t += 2) {
            const bool last = (t == nt - 2);
            const char* a1 = cA + (size_t)(t + 1) * kstep;
            const char* a2 = last ? nA : cA + (size_t)(t + 2) * kstep; const char* b2 = last ? nB : cB + (size_t)(t + 2) * kstep;
            const char* a3 = a2 + kstep; const char* b3 = b2 + kstep;
            PG8_LDB(B0, 0, 0); PG8_LDB(B1, 0, 1); PG8_SCHED; PG8_LDA(At, 0, 0); PG8_STAGE(PG8_SA(1, 1), a1 + hstepA, voffA);
            PG8_WAIT_V(8); PG8_WAIT_L(0); PG8_BAR; if (t == 0) { PG8_MMA0(0, 0, At, B0); PG8_MMA0(0, 1, At, B1); } else { PG8_MMA(0, 0, At, B0); PG8_MMA(0, 1, At, B1); } PG8_BAR; PG8_SCHED;
            PG8_LDA(At, 0, 1); PG8_STAGE(PG8_SB(0, 0), b2, voffB); PG8_STAGE(PG8_SB(0, 1), b2 + hstepB, voffB); PG8_STAGE(PG8_SA(0, 0), a2, voffA);
            PG8_WAIT_V(8); PG8_WAIT_L(0); PG8_BAR; if (t == 0) { PG8_MMA0(1, 0, At, B0); PG8_MMA0(1, 1, At, B1); } else { PG8_MMA(1, 0, At, B0); PG8_MMA(1, 1, At, B1); } PG8_BAR; PG8_SCHED;
            PG8_LDB(B0, 1, 0); PG8_LDB(B1, 1, 1); PG8_SCHED; PG8_LDA(At, 1, 0); PG8_STAGE(PG8_SA(0, 1), a2 + hstepA, voffA);
            PG8_WAIT_V(8); PG8_WAIT_L(0); PG8_BAR; PG8_MMA(0, 0, At, B0); PG8_MMA(0, 1, At, B1); PG8_BAR; PG8_SCHED;
            PG8_LDA(At, 1, 1); PG8_STAGE(PG8_SB(1, 0), b3, voffB); PG8_STAGE(PG8_SB(1, 1), b3 + hstepB, voffB); PG8_STAGE(PG8_SA(1, 0), a3, voffA);
            PG8_WAIT_V(8); PG8_WAIT_L(0); PG8_BAR; PG8_MMA(1, 0, At, B0); PG8_MMA(1, 1, At, B1); PG8_BAR; PG8_SCHED;
        }
        if (wr == 0) PG8_BAR;
        E(acc, cur, wr, wc, fr, fq, pre);
        if (!has_next) break;
        cur = nxt; cA = nA; cB = nB; ++ui;
        if (wr == 1) PG8_BAR;
    }
    PG8_WAIT_V(0);
    PG8_BAR;
#undef PG8_SA
#undef PG8_SB
#undef PG8_STAGE
#undef PG8_RSTEP_voffA
#undef PG8_RSTEP_voffB
#undef PG8_LDA
#undef PG8_LDB
#undef PG8_MMA
#undef PG8_MMA0
#undef PG8_WAIT_V
#undef PG8_WAIT_L
#undef PG8_BAR
#undef PG8_SCHED
}

typedef f32x4 Acc[2][2][4][2];
__device__ __forceinline__ void store8(bf16_t* p, f32x4 v0, f32x4 v1) {
    u32x4 w; w.x = cvt_pk_bf16(v0[0], v0[1]); w.y = cvt_pk_bf16(v0[2], v0[3]); w.z = cvt_pk_bf16(v1[0], v1[1]); w.w = cvt_pk_bf16(v1[2], v1[3]);
    *(u32x4*)p = w;
}

struct EpiPlain {
    bf16_t* O; int ldc;
    __device__ __forceinline__ void prefetch(float (&pre)[8], const Unit&, int, int) const {}
    __device__ __forceinline__ void operator()(const Acc& acc, const Unit& u, int wr, int wc, int fr_in, int fq_in, const float (&pre)[8]) const {
        int fr = fr_in, fq = fq_in; asm volatile("" : "+v"(fr), "+v"(fq));
        const int row0 = u.pm * BM + wr * 64 + fr, col0 = u.pn * BM + wc * 32 + 8 * fq;
#pragma unroll
        for (int ai = 0; ai < 2; ++ai)
#pragma unroll
            for (int m = 0; m < 4; ++m) { bf16_t* rowp = O + (size_t)(row0 + ai * HALF + m * 16) * ldc + col0;
#pragma unroll
                for (int bj = 0; bj < 2; ++bj) store8(rowp + bj * HALF, acc[ai][bj][m][0], acc[ai][bj][m][1]); }
    }
};
struct EpiProjA {
    bf16_t *XR, *GG, *MQ; const float* rs;
    __device__ __forceinline__ void prefetch(float (&pre)[8], const Unit&, int, int) const {}
    __device__ __forceinline__ void operator()(const Acc& acc, const Unit& u, int wr, int wc, int fr_in, int fq_in, const float (&pre)[8]) const {
        int fr = fr_in, fq = fq_in; asm volatile("" : "+v"(fr), "+v"(fq));
        const int pn = u.pn; bf16_t* base; int ld, colt, mode;
        if (pn < 3) { base = XR; ld = LRU_W; colt = pn * 256; mode = 0; } else if (pn < 6) { base = GG; ld = LRU_W; colt = (pn - 3) * 256; mode = 1; } else { base = MQ; ld = MEM_W; colt = 0; mode = 2; }
        const int row0 = u.pm * BM + wr * 64 + fr, col0 = colt + wc * 32 + 8 * fq;
        float rloc[8];
#pragma unroll
        for (int q = 0; q < 8; ++q) rloc[q] = rs[row0 + (q >> 2) * HALF + (q & 3) * 16];
#pragma unroll
        for (int ai = 0; ai < 2; ++ai)
#pragma unroll
            for (int m = 0; m < 4; ++m) { bf16_t* rowp = base + (size_t)(row0 + ai * HALF + m * 16) * ld + col0; const float rsv = rloc[ai * 4 + m];
#pragma unroll
                for (int bj = 0; bj < 2; ++bj) { f32x4 v0 = acc[ai][bj][m][0] * rsv, v1 = acc[ai][bj][m][1] * rsv;
                    if (mode == 1) {
#pragma unroll
                        for (int j = 0; j < 4; ++j) { v0[j] = gelu_tanh(v0[j]); v1[j] = gelu_tanh(v1[j]); } }
                    else if (mode == 2) { v0 = v0 * QSCALE; v1 = v1 * QSCALE; }
                    store8(rowp + bj * HALF, v0, v1); } }
    }
};
struct EpiMkv {
    bf16_t *MK, *MVT;
    __device__ __forceinline__ void prefetch(float (&pre)[8], const Unit&, int, int) const {}
    __device__ __forceinline__ void operator()(const Acc& acc, const Unit& u, int wr, int wc, int fr_in, int fq_in, const float (&pre)[8]) const {
        int fr = fr_in, fq = fq_in; asm volatile("" : "+v"(fr), "+v"(fq));
        const int l = u.pn >> 1;
        if ((u.pn & 1) == 0) {
            bf16_t* O = MK + (size_t)l * TM * 256; const int row0 = u.pm * BM + wr * 64 + fr, col0 = wc * 32 + 8 * fq;
#pragma unroll
            for (int ai = 0; ai < 2; ++ai)
#pragma unroll
                for (int m = 0; m < 4; ++m) { bf16_t* rowp = O + (size_t)(row0 + ai * HALF + m * 16) * 256 + col0;
#pragma unroll
                    for (int bj = 0; bj < 2; ++bj) store8(rowp + bj * HALF, acc[ai][bj][m][0], acc[ai][bj][m][1]); }
        } else {
            bf16_t* O = MVT + (size_t)l * TM * 256 + (size_t)u.pm * 256 * 256;
#pragma unroll
            for (int ai = 0; ai < 2; ++ai)
#pragma unroll
                for (int m = 0; m < 4; ++m) { const int mi = ai * HALF + wr * 64 + m * 16 + fr;
#pragma unroll
                    for (int bj = 0; bj < 2; ++bj)
#pragma unroll
                        for (int n = 0; n < 2; ++n)
#pragma unroll
                            for (int j = 0; j < 4; ++j) { const int c = bj * HALF + wc * 32 + 8 * fq + 4 * n + j; O[(size_t)c * 256 + mi] = (bf16_t)(cvt_pk_bf16(acc[ai][bj][m][n][j], 0.f) & 0xffffu); } }
        }
    }
};
struct EpiSwiglu {
    bf16_t* O; const float* rs;
    __device__ __forceinline__ void prefetch(float (&pre)[8], const Unit& u, int wr, int fr) const {
#pragma unroll
        for (int q = 0; q < 8; ++q) pre[q] = rs[u.pm * BM + wr * 64 + fr + (q >> 2) * HALF + (q & 3) * 16]; }
    __device__ __forceinline__ void operator()(const Acc& acc, const Unit& u, int wr, int wc, int fr_in, int fq_in, const float (&pre)[8]) const {
        int fr = fr_in, fq = fq_in; asm volatile("" : "+v"(fr), "+v"(fq));
        const int row0 = u.pm * BM + wr * 64 + fr, col0 = u.pn * HALF + wc * 32 + 8 * fq;
#pragma unroll
        for (int ai = 0; ai < 2; ++ai)
#pragma unroll
            for (int m = 0; m < 4; ++m) { bf16_t* rowp = O + (size_t)(row0 + ai * HALF + m * 16) * DFF + col0; const float rsv = pre[ai * 4 + m];
                f32x4 o[2]; const float c1 = -rsv * LOG2E, c2 = rsv * rsv;
#pragma unroll
                for (int n = 0; n < 2; ++n) { const f32x4 g4 = acc[ai][0][m][n], u4 = acc[ai][1][m][n]; const f32x4 t4 = g4 * c1; f32x4 d4;
#pragma unroll
                    for (int j = 0; j < 4; ++j) d4[j] = ex2(t4[j]);
                    d4 = d4 + 1.0f; f32x4 q4;
#pragma unroll
                    for (int j = 0; j < 4; ++j) q4[j] = rcpf_(d4[j]);
                    o[n] = ((g4 * u4) * c2) * q4; }
                store8(rowp, o[0], o[1]); }
    }
};
struct EpiKvq {
    bf16_t *KS, *VST, *Q; const float* rope; const float* rs;
    __device__ __forceinline__ void prefetch(float (&pre)[8], const Unit&, int, int) const {}
    __device__ __forceinline__ void operator()(const Acc& acc, const Unit& u, int wr, int wc, int fr_in, int fq_in, const float (&pre)[8]) const {
        int fr = fr_in, fq = fq_in; asm volatile("" : "+v"(fr), "+v"(fq));
        const int pn = u.pn;
        if (pn == 1) {
#pragma unroll
            for (int ai = 0; ai < 2; ++ai)
#pragma unroll
                for (int m = 0; m < 4; ++m) { const int row = u.pm * BM + ai * HALF + wr * 64 + m * 16 + fr; const int b = row >> 12, s = row & (SEQ - 1); const float rsv = rs[row];
                    bf16_t* O = VST + (size_t)b * 256 * SEQ + s;
#pragma unroll
                    for (int bj = 0; bj < 2; ++bj)
#pragma unroll
                        for (int n = 0; n < 2; ++n)
#pragma unroll
                            for (int j = 0; j < 4; ++j) { const int c = bj * HALF + wc * 32 + 8 * fq + 4 * n + j; O[(size_t)c * SEQ] = (bf16_t)(cvt_pk_bf16(acc[ai][bj][m][n][j] * rsv, 0.f) & 0xffffu); }
                    __builtin_amdgcn_sched_barrier(0); }
            return;
        }
        bf16_t* base; int ld, colt; float sc; bool do_rope;
        if (pn == 0) { base = KS; ld = 256; colt = 0; sc = 1.f; do_rope = true; }
        else { base = Q; ld = 1024; colt = (pn - 2) * 256; sc = QSCALE; do_rope = (pn < 5); }
        const int row0 = u.pm * BM + wr * 64 + fr, col0 = colt + wc * 32 + 8 * fq;
        const bool rot_lane = do_rope && ((wc & 1) == 0) && (fq < 2);
        const float sgn = (fq == 0) ? -1.f : 1.f;
#pragma unroll
        for (int ai = 0; ai < 2; ++ai)
#pragma unroll
            for (int m = 0; m < 4; ++m) { const int row = row0 + ai * HALF + m * 16; bf16_t* rowp = base + (size_t)row * ld + col0;
                const float* rp = rope + (size_t)(row & (SEQ - 1)) * 16; const float rsc = rs[row] * sc;
#pragma unroll
                for (int n = 0; n < 2; ++n) { const f32x4 cs = *(const f32x4*)(rp + 4 * n), sn = *(const f32x4*)(rp + 8 + 4 * n);
#pragma unroll
                    for (int bj = 0; bj < 2; ++bj) { float v[4];
#pragma unroll
                        for (int j = 0; j < 4; ++j) { const float x = acc[ai][bj][m][n][j]; const float pr = __shfl_xor(x, 16);
                            float o = x; if (rot_lane) o = x * cs[j] + sgn * pr * sn[j];
                            v[j] = o * rsc; }
                        u32x2 w; w.x = cvt_pk_bf16(v[0], v[1]); w.y = cvt_pk_bf16(v[2], v[3]); *(u32x2*)(rowp + bj * HALF + 4 * n) = w; }
                    __builtin_amdgcn_sched_barrier(0); }
                }
    }
};
}

constexpr int KPITCH = 144;
__device__ __forceinline__ void load_q(bf16x8 (&qr)[4], const bf16_t* Qp, int ldq, int lane) {
#pragma unroll
    for (int d0 = 0; d0 < 4; ++d0) qr[d0] = *(const bf16x8*)(Qp + (size_t)(lane & 31) * ldq + d0 * 16 + (lane >> 5) * 8);
}
template <int NKB, bool SWA>
__device__ __forceinline__ void attn_task(bf16x8 (&qr)[4], const bf16_t* Qnext, int ldq, const LAS char* Kl, const LAS char* Vl, int vpitch, int key0,
                                          bf16_t* Op, int ldo, float sink2, bool has_prev, int ci0  , int lane) {
    const int r32 = lane & 31, hi = lane >> 5;
    f32x16 p[NKB];
#pragma unroll
    for (int kb = 0; kb < NKB; ++kb) {
        const LAS char* kp = Kl + (key0 + 32 * kb + r32) * KPITCH + hi * 16;
        const f32x16 z16 = {0.f, 0.f, 0.f, 0.f, 0.f, 0.f, 0.f, 0.f, 0.f, 0.f, 0.f, 0.f, 0.f, 0.f, 0.f, 0.f};
#pragma unroll
        for (int d0 = 0; d0 < 4; ++d0) { const bf16x8 a = *(const LAS bf16x8*)(kp + d0 * 32); p[kb] = __builtin_amdgcn_mfma_f32_32x32x16_bf16(a, qr[d0], d0 ? p[kb] : z16, 0, 0, 0); }
    }
    float m = -INFINITY;
    if (SWA) {
#pragma unroll
        for (int kb = 0; kb < NKB; ++kb)
#pragma unroll
            for (int r = 0; r < 16; ++r) { const int cr = (r & 3) + 8 * (r >> 2) + 4 * hi; const int rel = 32 * kb + cr - r32;
                const int kwin = ci0 + 32 * kb + cr;
                const bool ok = (rel >= 1) && (rel <= 128) && (has_prev || kwin >= 128);
                if (!ok) p[kb][r] = -INFINITY; m = fmaxf(m, p[kb][r]); }
    } else {
#pragma unroll
        for (int kb = 0; kb < NKB; ++kb)
#pragma unroll
            for (int r = 0; r < 16; ++r) m = fmaxf(m, p[kb][r]);
    }
    m = fmaxf(m, __shfl_xor(m, 32));
    if (SWA) m = fmaxf(m, sink2);
    float sum = 0.f;
#pragma unroll
    for (int kb = 0; kb < NKB; ++kb)
#pragma unroll
        for (int r = 0; r < 16; ++r) { const float e = ex2(p[kb][r] - m); p[kb][r] = e; sum += e; }
    sum += __shfl_xor(sum, 32);
    if (SWA) sum += ex2(sink2 - m);
    const float inv = 1.f / sum;
    f32x16 o[2]; const f32x16 zo16 = {0.f, 0.f, 0.f, 0.f, 0.f, 0.f, 0.f, 0.f, 0.f, 0.f, 0.f, 0.f, 0.f, 0.f, 0.f, 0.f};
#pragma unroll
    for (int kb = 0; kb < NKB; ++kb)
#pragma unroll
        for (int ks = 0; ks < 2; ++ks) {
            u32x4 pw; pw.x = cvt_pk_bf16(p[kb][8 * ks + 0], p[kb][8 * ks + 1]); pw.y = cvt_pk_bf16(p[kb][8 * ks + 2], p[kb][8 * ks + 3]);
            pw.z = cvt_pk_bf16(p[kb][8 * ks + 4], p[kb][8 * ks + 5]); pw.w = cvt_pk_bf16(p[kb][8 * ks + 6], p[kb][8 * ks + 7]);
            const bf16x8 pf = __builtin_bit_cast(bf16x8, pw);
            const int kbase = key0 + 32 * kb + 16 * ks + 4 * hi;
#pragma unroll
            for (int nb = 0; nb < 2; ++nb) { const LAS char* vp = Vl + (32 * nb + r32) * vpitch + kbase * 2;
                const s16x4 lo = *(const LAS s16x4*)vp, hh = *(const LAS s16x4*)(vp + 16);
                const bf16x8 vf = (bf16x8){lo[0], lo[1], lo[2], lo[3], hh[0], hh[1], hh[2], hh[3]};
                o[nb] = __builtin_amdgcn_mfma_f32_32x32x16_bf16(vf, pf, (kb | ks) ? o[nb] : zo16, 0, 0, 0); }
        }
#pragma unroll
    for (int d0 = 0; d0 < 4; ++d0) qr[d0] = *(const bf16x8*)(Qnext + (size_t)r32 * ldq + d0 * 16 + hi * 8);
    bf16_t* orow = Op + (size_t)r32 * ldo;
#pragma unroll
    for (int nb = 0; nb < 2; ++nb)
#pragma unroll
        for (int g4 = 0; g4 < 4; ++g4) { u32x2 w; w.x = cvt_pk_bf16(o[nb][4 * g4 + 0] * inv, o[nb][4 * g4 + 1] * inv); w.y = cvt_pk_bf16(o[nb][4 * g4 + 2] * inv, o[nb][4 * g4 + 3] * inv);
            *(u32x2*)(orow + 32 * nb + 8 * g4 + 4 * hi) = w; }
}

__device__ __forceinline__ void load_k_tile(LAS char* Kl, const bf16_t* src, int gp, int nrows, int zero_rows, int tid) {
    for (int c = tid; c < nrows * 8; c += 512) { const int r = c >> 3, ch = c & 7; u32x4 v = (u32x4){0u, 0u, 0u, 0u};
        if (r >= zero_rows) v = *(const u32x4*)(src + (ptrdiff_t)r * gp + ch * 8);
        *(LAS u32x4*)(Kl + r * KPITCH + ch * 16) = v; }
}
__device__ __forceinline__ void load_vt_tile(LAS char* Vl, int vpitch, const bf16_t* src, int gp, int nkeys, int zero_keys, int tid) {
    const int cpr = nkeys >> 3;
    for (int c = tid; c < 64 * cpr; c += 512) { const int d = c / cpr, ch = c - d * cpr; u32x4 v = (u32x4){0u, 0u, 0u, 0u};
        if (ch * 8 >= zero_keys) v = *(const u32x4*)(src + (ptrdiff_t)d * gp + ch * 8);
        LAS char* dst = Vl + d * vpitch + ch * 16; *(LAS u32x2*)dst = (u32x2){v.x, v.y}; *(LAS u32x2*)(dst + 8) = (u32x2){v.z, v.w}; }
}

__device__ __forceinline__ const bf16_t* mem_qptr(const bf16_t* Qb, int ldq, int qcol0, int unit, int wid) {
    const int b = unit >> 6, h = (unit >> 4) & 3, c = unit & 15; return Qb + ((size_t)b * SEQ + c * 256 + wid * 32) * ldq + qcol0 + h * 64; }
__device__ __forceinline__ void mem_attn_phase(LAS char* lds, const bf16_t* Qb, int ldq, int qcol0, const bf16_t* MK, const bf16_t* MVT, bf16_t* Y, int wg, int nwg) {
    const int tid = threadIdx.x, wid = tid >> 6, lane = tid & 63;
    LAS char* Kl = lds; LAS char* Vl = lds + 256 * KPITCH; constexpr int VP = 520; constexpr int NU = BATCH * 4 * 16;
    bf16x8 qr[4];
    if (wg < NU) load_q(qr, mem_qptr(Qb, ldq, qcol0, wg, wid), ldq, lane);
    for (int unit = wg; unit < NU; unit += nwg) {
        const int b = unit >> 6, h = (unit >> 4) & 3, c = unit & 15;
        load_k_tile(Kl, MK + (size_t)b * NMEM * 256 + h * 64, 256, 256, 0, tid);
        load_vt_tile(Vl, VP, MVT + ((size_t)b * 256 + h * 64) * 256, 256, 256, 0, tid);
        __syncthreads();
        const size_t row = (size_t)b * SEQ + c * 256 + wid * 32;
        const int nu = (unit + nwg < NU) ? unit + nwg : unit;
        attn_task<8, false>(qr, mem_qptr(Qb, ldq, qcol0, nu, wid), ldq, Kl, Vl, VP, 0, Y + row * 1024 + LRU_W + h * 64, 1024, 0.f, true, 0, lane);
        __syncthreads();
    }
}
__device__ __forceinline__ const bf16_t* swa_qptr(const bf16_t* Q, int unit, int task) {
    const int b = unit >> 6, np = (unit >> 2) & 15, kh = unit & 3; const int blk = task / 12, rem = task - blk * 12, g = rem >> 2, j = rem & 3;
    return Q + ((size_t)b * SEQ + (2 * np + blk) * 128 + j * 32) * 1024 + (kh * 3 + g) * 64; }
__device__ __forceinline__ void swa_phase(LAS char* lds, const bf16_t* Q, const bf16_t* KS, const bf16_t* VST, const float* sinks, bf16_t* Y, int wg, int nwg) {
    const int tid = threadIdx.x, wid = tid >> 6, lane = tid & 63;
    LAS char* Kl = lds; LAS char* Vl = lds + 384 * KPITCH; constexpr int VP = 776; constexpr int NU = BATCH * 16 * 4;
    bf16x8 qr[4];
    if (wg < NU) load_q(qr, swa_qptr(Q, wg, wid), 1024, lane);
    for (int unit = wg; unit < NU; unit += nwg) {
        const int b = unit >> 6, np = (unit >> 2) & 15, kh = unit & 3;
        const int s0 = (2 * np - 1) * 128;
        const int zk = (np == 0) ? 128 : 0;
        load_k_tile(Kl, KS + ((ptrdiff_t)b * SEQ + s0) * 256 + kh * 64, 256, 384, zk, tid);
        load_vt_tile(Vl, VP, VST + ((ptrdiff_t)b * 256 + kh * 64) * SEQ + s0, SEQ, 384, zk, tid);
        __syncthreads();
#pragma unroll 1
        for (int task = wid; task < 24; task += 8) {
            const int blk = task / 12, rem = task - blk * 12, g = rem >> 2, j = rem & 3;
            const int head = kh * 3 + g;
            const size_t row = (size_t)b * SEQ + (2 * np + blk) * 128 + j * 32;
            const float sink2 = sinks[head] * LOG2E;
            const bf16_t* qn = (task + 8 < 24) ? swa_qptr(Q, unit, task + 8) : swa_qptr(Q, (unit + nwg < NU) ? unit + nwg : unit, wid);
            attn_task<5, true>(qr, qn, 1024, Kl, Vl, VP, 128 * blk + 32 * j, Y + row * 1024 + head * 64, 1024, sink2, (2 * np + blk) > 0, 32 * j, lane);
        }
        __syncthreads();
    }
}

struct RowPair { f32x4 v[2][4]; u32x2 mw[2][4]; int rows[2]; };
template <bool IN_BF>
__device__ __forceinline__ void rp_load(RowPair& P, const void* hin_, const bf16_t* mixed, int row, int ngw, int nrows, int lane) {
    P.rows[0] = row; P.rows[1] = (row + ngw < nrows) ? row + ngw : row;
#pragma unroll
    for (int q = 0; q < 2; ++q) {
        if (IN_BF) { const u32x2* hr = (const u32x2*)((const bf16_t*)hin_ + (size_t)P.rows[q] * D) + lane;
#pragma unroll
            for (int j = 0; j < 4; ++j) { const u32x2 w = hr[64 * j]; P.v[q][j] = (f32x4){__uint_as_float(w.x), __uint_as_float(w.y), 0.f, 0.f}; } }
        else { const f32x4* hr = (const f32x4*)((const float*)hin_ + (size_t)P.rows[q] * D) + lane;
#pragma unroll
            for (int j = 0; j < 4; ++j) P.v[q][j] = hr[64 * j]; }
        if (mixed) { const u32x2* mr = (const u32x2*)(mixed + (size_t)P.rows[q] * D) + lane;
#pragma unroll
            for (int j = 0; j < 4; ++j) P.mw[q][j] = mr[64 * j]; }
    }
}
template <bool IN_BF, bool OUT_BF>
__device__ __forceinline__ void rp_proc(RowPair& P, const bf16_t* mixed, const float* g_post, void* hout_, const float* g_next, bf16_t* HNo, float* RSo, int lane) {
#pragma unroll
    for (int q = 0; q < 2; ++q) {
        f32x4 v[4];
#pragma unroll
        for (int j = 0; j < 4; ++j) { if (IN_BF) { const unsigned wx = __float_as_uint(P.v[q][j][0]), wy = __float_as_uint(P.v[q][j][1]); v[j] = (f32x4){bf_lo(wx), bf_hi(wx), bf_lo(wy), bf_hi(wy)}; } else v[j] = P.v[q][j]; }
        if (mixed) { f32x4 mv[4]; float s = 0.f;
#pragma unroll
            for (int j = 0; j < 4; ++j) { const u32x2 w = P.mw[q][j]; mv[j] = (f32x4){bf_lo(w.x), bf_hi(w.x), bf_lo(w.y), bf_hi(w.y)}; s += (mv[j][0] * mv[j][0] + mv[j][1] * mv[j][1]) + (mv[j][2] * mv[j][2] + mv[j][3] * mv[j][3]); }
            const float rstd = 1.f / __builtin_sqrtf(wave_sum(s) * (1.f / D) + EPS);
#pragma unroll
            for (int j = 0; j < 4; ++j) { const f32x4 gp = *((const f32x4*)g_post + lane + 64 * j); v[j] = v[j] + mv[j] * rstd * gp; } }
        if (hout_) {
            if (OUT_BF) { u32x2* ho = (u32x2*)((bf16_t*)hout_ + (size_t)P.rows[q] * D) + lane;
#pragma unroll
                for (int j = 0; j < 4; ++j) { u32x2 w; w.x = cvt_pk_bf16(v[j][0], v[j][1]); w.y = cvt_pk_bf16(v[j][2], v[j][3]); ho[64 * j] = w; } }
            else { f32x4* ho = (f32x4*)((float*)hout_ + (size_t)P.rows[q] * D) + lane;
#pragma unroll
                for (int j = 0; j < 4; ++j) ho[64 * j] = v[j]; } }
        if (HNo || RSo) { float s = 0.f;
#pragma unroll
            for (int j = 0; j < 4; ++j) s += (v[j][0] * v[j][0] + v[j][1] * v[j][1]) + (v[j][2] * v[j][2] + v[j][3] * v[j][3]);
            const float rstd = 1.f / __builtin_sqrtf(wave_sum(s) * (1.f / D) + EPS);
            if (RSo) { if (lane == 0) RSo[P.rows[q]] = rstd; }
            else { u32x2* o8 = (u32x2*)(HNo + (size_t)P.rows[q] * D) + lane;
#pragma unroll
                for (int j = 0; j < 4; ++j) { f32x4 gn = (f32x4){1.f, 1.f, 1.f, 1.f}; if (g_next) gn = *((const f32x4*)g_next + lane + 64 * j); const f32x4 o = v[j] * rstd * gn;
                    u32x2 w; w.x = cvt_pk_bf16(o[0], o[1]); w.y = cvt_pk_bf16(o[2], o[3]); o8[64 * j] = w; } } }
    }
}
template <bool IN_BF, bool OUT_BF>
__device__ __forceinline__ void norm_rows(const void* hin_, const bf16_t* mixed, const float* g_post, void* hout_, const float* g_next, bf16_t* HNo, float* RSo, int nrows, int gw, int ngw, int lane) {
    const int step = 2 * ngw;
    if (gw >= nrows) return;
    RowPair A, B;
    rp_load<IN_BF>(A, hin_, mixed, gw, ngw, nrows, lane);
    for (int row = gw; row < nrows; row += 2 * step) {
        const bool hasB = row + step < nrows, hasA2 = row + 2 * step < nrows;
        if (hasB) rp_load<IN_BF>(B, hin_, mixed, row + step, ngw, nrows, lane);
        rp_proc<IN_BF, OUT_BF>(A, mixed, g_post, hout_, g_next, HNo, RSo, lane);
        if (hasA2) rp_load<IN_BF>(A, hin_, mixed, row + 2 * step, ngw, nrows, lane);
        if (hasB) rp_proc<IN_BF, OUT_BF>(B, mixed, g_post, hout_, g_next, HNo, RSo, lane);
    }
}
__device__ __forceinline__ void tr_item(const float* W, int ldw, int k0, int n0, bf16_t* WT, int ldt, int dst_row0, const float* gk, LAS float* scr, int lane) {
    float wv[32];
#pragma unroll
    for (int i = 0; i < 32; ++i) { const int kk = 2 * i + (lane >> 5); wv[i] = W[(size_t)(k0 + kk) * ldw + n0 + (lane & 31)]; }
#pragma unroll
    for (int i = 0; i < 32; ++i) { const int kk = 2 * i + (lane >> 5); float w = wv[i]; if (gk) w *= gk[k0 + kk]; scr[kk * 33 + (lane & 31)] = w; }
    asm volatile("s_waitcnt lgkmcnt(0)" ::: "memory");
    const int c = lane & 7;
#pragma unroll
    for (int j = 0; j < 4; ++j) { const int n = (lane >> 3) + 8 * j; const LAS float* s = scr + (8 * c) * 33 + n;
        u32x4 o; o.x = cvt_pk_bf16(s[0 * 33], s[1 * 33]); o.y = cvt_pk_bf16(s[2 * 33], s[3 * 33]); o.z = cvt_pk_bf16(s[4 * 33], s[5 * 33]); o.w = cvt_pk_bf16(s[6 * 33], s[7 * 33]);
        *(u32x4*)(WT + (size_t)(dst_row0 + n) * ldt + k0 + 8 * c) = o; }
    asm volatile("s_waitcnt lgkmcnt(0)" ::: "memory");
}
__device__ __forceinline__ void sincos_d(double a, double& s, double& c) {
    const double k = __builtin_rint(a * 0.63661977236758134308);
    double r = __builtin_fma(-k, 1.57079632679489655800, a); r = __builtin_fma(-k, 6.123233995736766e-17, r);
    const double r2 = r * r;
    const double sp = r * (1.0 + r2 * (-1.0 / 6.0 + r2 * (1.0 / 120.0 + r2 * (-1.0 / 5040.0 + r2 * (1.0 / 362880.0 + r2 * (-1.0 / 39916800.0 + r2 * (1.0 / 6227020800.0)))))));
    const double cp = 1.0 + r2 * (-0.5 + r2 * (1.0 / 24.0 + r2 * (-1.0 / 720.0 + r2 * (1.0 / 40320.0 + r2 * (-1.0 / 3628800.0 + r2 * (1.0 / 479001600.0 + r2 * (-1.0 / 87178291200.0)))))));
    const int q = ((int)k) & 3;
    s = (q == 0) ? sp : (q == 1) ? cp : (q == 2) ? -sp : -cp;
    c = (q == 0) ? cp : (q == 1) ? -sp : (q == 2) ? -cp : sp;
}

struct Args { const float* in[23]; float* out; unsigned char* ws; int ph_lo, ph_hi, coop, pad; };
enum { I_X = 0, I_MEM, I_NMIXPRE, I_NMIXPOST, I_NFFNPRE, I_NFFNPOST, I_MEMNORM, I_WMEMKV, I_WINA, I_CONVW, I_CONVB, I_WGR, I_BGR, I_WGI, I_BGI, I_LAM, I_NKV, I_WKV, I_WINB, I_SINKS, I_WOUT, I_WFFI, I_WFFO };
constexpr int NPH = 17;

#define Wmkv ((bf16_t*)(args.ws + O_WMKV))
#define Wina ((bf16_t*)(args.ws + O_WINA))
#define Wg ((bf16_t*)(args.ws + O_WG))
#define Wkvq ((bf16_t*)(args.ws + O_WKVQ))
#define Wout ((bf16_t*)(args.ws + O_WOUT))
#define Wffi ((bf16_t*)(args.ws + O_WFFI))
#define Wffo ((bf16_t*)(args.ws + O_WFFO))
#define MEMN ((bf16_t*)(args.ws + O_MEMN))
#define MK ((bf16_t*)(args.ws + O_MK))
#define MVT ((bf16_t*)(args.ws + O_MVT))
#define HN ((bf16_t*)(args.ws + O_HN))
#define MIXED ((bf16_t*)(args.ws + O_MIXED))
#define KS ((bf16_t*)(args.ws + O_KS))
#define VST ((bf16_t*)(args.ws + O_VST))
#define XRLA ((bf16_t*)(args.ws + O_XRLA))
#define XC ((bf16_t*)(args.ws + O_XC))
#define GG ((bf16_t*)(args.ws + O_GG))
#define GATES ((bf16_t*)(args.ws + O_GATES))
#define MQ ((bf16_t*)(args.ws + O_MQ))
#define Y ((bf16_t*)(args.ws + O_Y))
#define Y1 ((bf16_t*)(args.ws + O_Y1))
#define HB ((bf16_t*)(args.ws + O_HB))
#define RS ((float*)(args.ws + O_RS))
#define Q ((bf16_t*)(args.ws + O_Q))
#define FF ((bf16_t*)(args.ws + O_FF))
#define rope ((float*)(args.ws + O_ROPE))
#define clam ((float*)(args.ws + O_CLAM))
#define H (args.out)
#define in (args.in)
#define XB_TMO      128
#define XB_XCNT(j)  (256  + 64 * (j))
#define XB_XSUB(j)  (1280 + 64 * (j))
#define XB_XGEN(j)  (2304 + 64 * (j))
#define XB_TOP      3328
#define XB_TOPGEN   3392
#define XCD_BAR_WORDS 3456
#define XB_SPIN_CAP (1u << 22)
__device__ __forceinline__ unsigned xb_ld(unsigned* p)              { return __hip_atomic_load(p, __ATOMIC_RELAXED, __HIP_MEMORY_SCOPE_AGENT); }
__device__ __forceinline__ unsigned xb_add(unsigned* p, unsigned v) { return __hip_atomic_fetch_add(p, v, __ATOMIC_RELAXED, __HIP_MEMORY_SCOPE_AGENT); }
__device__ __forceinline__ unsigned xb_xcc_id() { return (unsigned)__builtin_amdgcn_s_getreg((3 << 11) | 20) & 0xFu; }
#define XB_SPIN(cond, bar) do { unsigned _sp = 0; while (cond) { __builtin_amdgcn_s_sleep(1); \
    if ((++_sp & 255u) == 0u) { if (xb_ld(&(bar)[XB_TMO])) break; if (_sp > XB_SPIN_CAP) { atomicAdd(&(bar)[XB_TMO], 1u); break; } } } } while (0)
__device__ __forceinline__ void xcd_barrier_complete(unsigned* bar, unsigned x, unsigned& nloc, unsigned& nx) {
    const unsigned G = gridDim.x * gridDim.y * gridDim.z;
    unsigned sum, cnt, mine, sp = 0u;
    for (;;) {
        sum = 0u; cnt = 0u; mine = 0u;
#pragma unroll
        for (unsigned j = 0; j < 16; ++j) { const unsigned c = xb_ld(&bar[XB_XCNT(j)]); sum += c; cnt += (c > 0u) ? 1u : 0u; mine = (j == x) ? c : mine; }
        if (sum == G) break;
        __builtin_amdgcn_s_sleep(1);
        if ((++sp & 255u) == 0u) { if (xb_ld(&bar[XB_TMO])) break; if (sp > XB_SPIN_CAP) { atomicAdd(&bar[XB_TMO], 1u); break; } }
    }
    nloc = mine > 0u ? mine : 1u; nx = cnt > 0u ? cnt : 1u;
}
__device__ __forceinline__ void xcd_barrier(unsigned* bar, volatile LAS unsigned* st) {
    asm volatile("s_waitcnt vmcnt(0)" ::: "memory");
    __syncthreads();
    if (threadIdx.x == 0) {
        __builtin_amdgcn_s_waitcnt(0);
        const unsigned x = xb_xcc_id();
        unsigned nloc = st[0], nx = st[1];
        if (nloc == 0u) { xcd_barrier_complete(bar, x, nloc, nx); st[0] = nloc; st[1] = nx; }
        const unsigned old = xb_add(&bar[XB_XSUB(x)], 1u);
        const unsigned gen = old / nloc;
        if (old + 1u == (gen + 1u) * nloc) {
            __builtin_amdgcn_fence(__ATOMIC_RELEASE, "agent");
            asm volatile("s_waitcnt vmcnt(0)" ::: "memory");
            const unsigned og = xb_add(&bar[XB_TOP], 1u);
            const unsigned tg = og / nx;
            if (og + 1u == (tg + 1u) * nx) xb_add(&bar[XB_TOPGEN], 1u);
            else XB_SPIN(xb_ld(&bar[XB_TOPGEN]) == tg, bar);
            __builtin_amdgcn_fence(__ATOMIC_ACQUIRE, "agent");
            xb_add(&bar[XB_XGEN(x)], 1u);
            asm volatile("s_waitcnt vmcnt(0)" ::: "memory");
        } else {
            XB_SPIN(xb_ld(&bar[XB_XGEN(x)]) == gen, bar);
            __builtin_amdgcn_fence(__ATOMIC_ACQUIRE, "agent");
            asm volatile("s_waitcnt vmcnt(0)" ::: "memory");
        }
    }
    __syncthreads();
}
typedef const __attribute__((address_space(4))) Args* ArgsP;
__device__ __forceinline__ ArgsP get_args() { const unsigned long long a = (unsigned long long)__builtin_amdgcn_kernarg_segment_ptr(); unsigned lo32 = (unsigned)a, hi32 = (unsigned)(a >> 32);
    asm volatile("" : "+v"(lo32), "+v"(hi32)); lo32 = __builtin_amdgcn_readfirstlane(lo32); hi32 = __builtin_amdgcn_readfirstlane(hi32);
    return (ArgsP)(((unsigned long long)hi32 << 32) | lo32); }
#define args (*get_args())
__global__ void __launch_bounds__(512, 2) fwd_mega(Args args_by_value) {
    extern __shared__ __attribute__((aligned(16))) unsigned char lds_raw[];
    LAS unsigned char* lds = (LAS unsigned char*)lds_raw;
    const int G = gridDim.x, wg = blockIdx.x;
#define PHASE_IDS int tid = threadIdx.x; asm volatile("" : "+v"(tid)); const int lane = tid & 63, wave = __builtin_amdgcn_readfirstlane(tid >> 6); const int gw = wg * 8 + wave, ngw = G * 8; (void)lane; (void)gw; (void)ngw
    const int lo = args_by_value.ph_lo, hi = args_by_value.ph_hi, coop = args_by_value.coop;
#ifndef PHMASK
#define PHMASK 0x1FFFF
#endif
#ifndef DBL
#define DBL 0x0
#endif
#define NREP(k) ((((DBL) >> (k)) & 1) + 1)
#define IN(k) ((((PHMASK) >> (k)) & 1) && lo <= (k) && (k) < hi)
    if (coop == 2) cg::this_grid().sync();
    volatile LAS unsigned* xb_st = (volatile LAS unsigned*)(lds + LDS_BYTES - 64);
    if (coop) { if (threadIdx.x == 0) { xb_st[0] = 0u; xb_st[1] = 0u; (void)xb_add(&((unsigned*)args.ws)[XB_XCNT(xb_xcc_id())], 1u); } }
#define SYNC(k) do { if (coop && IN((k) + 1)) { xcd_barrier((unsigned*)args.ws, xb_st); } } while (0)

    if (IN(0)) for (int rep = 0; rep < NREP(0); ++rep) {
        PHASE_IDS;
        LAS float* scr = (LAS float*)(lds + wave * 16384);
        constexpr int I_MKV = 2 * 16 * 16, I_INA = 16 * 56, I_G = 12 * 2 * 4, I_KV = 16 * 16, I_INB = 16 * 32, I_OUT = 2 * 16 * 32, I_FFI = 2 * 16 * 176, I_FFO = 2 * 44 * 32;
        constexpr int NITEMS = I_MKV + I_INA + I_G + I_KV + I_INB + I_OUT + I_FFI + I_FFO;
        for (int it = gw; it < NITEMS; it += ngw) {
            int r = it;
            if (r < I_MKV) { const int l = r / 256, q = r % 256, kb = q / 16, nb = q % 16; tr_item(in[I_WMEMKV] + (size_t)l * 1024 * 512, 512, kb * 64, nb * 32, Wmkv, 1024, l * 512 + nb * 32, nullptr, scr, lane); continue; } r -= I_MKV;
            if (r < I_INA) { const int kb = r / 56, nb = r % 56; tr_item(in[I_WINA], A_IN, kb * 64, nb * 32, Wina, 1024, nb * 32, in[I_NMIXPRE], scr, lane); continue; } r -= I_INA;
            if (r < I_G) { const int mat = r / 8, q = r % 8, kb = q / 4, nb = q % 4; const int isI = mat / 6, h = mat % 6;
                tr_item((isI ? in[I_WGI] : in[I_WGR]) + (size_t)h * 128 * 128, 128, kb * 64, nb * 32, Wg + (size_t)h * 256 * 128, 128, isI * 128 + nb * 32, nullptr, scr, lane); continue; } r -= I_G;
            if (r < I_KV) { const int kb = r / 16, nb = r % 16; tr_item(in[I_WKV], 512, kb * 64, nb * 32, Wkvq, 1024, nb * 32, in[I_NKV], scr, lane); continue; } r -= I_KV;
            if (r < I_INB) { const int kb = r / 32, nb = r % 32; tr_item(in[I_WINB], 1024, kb * 64, nb * 32, Wkvq, 1024, 512 + nb * 32, in[I_NMIXPRE] + 1024, scr, lane); continue; } r -= I_INB;
            if (r < I_OUT) { const int l = r / 512, q = r % 512, kb = q / 32, nb = q % 32; tr_item(in[I_WOUT] + (size_t)l * 1024 * 1024, 1024, kb * 64, nb * 32, Wout + (size_t)l * 1024 * 1024, 1024, nb * 32, nullptr, scr, lane); continue; } r -= I_OUT;
            if (r < I_FFI) { const int l = r / 2816, q = r % 2816, kb = q / 176, nb = q % 176; const int c0 = nb * 32; const int isU = c0 >= DFF, f = c0 - isU * DFF;
                tr_item(in[I_WFFI] + (size_t)l * 1024 * 5632, 5632, kb * 64, c0, Wffi + (size_t)l * 5632 * 1024, 1024, (f / 128) * 256 + isU * 128 + (f % 128), in[I_NFFNPRE] + l * 1024, scr, lane); continue; } r -= I_FFI;
            { const int l = r / 1408, q = r % 1408, kb = q / 32, nb = q % 32; tr_item(in[I_WFFO] + (size_t)l * DFF * 1024, 1024, kb * 64, nb * 32, Wffo + (size_t)l * 1024 * DFF, DFF, nb * 32, nullptr, scr, lane); }
        }
        for (int e = wg * 512 + tid; e < SEQ * 8; e += G * 512) { const int s = e >> 3, i = e & 7;
            const double inv_freq[8] = {1.0, 0.19392274474868576, 0.03760603093086393, 0.007292664737217109, 0.001414213562373095, 0.0002742481756762073, 5.318295896944988e-05, 1.031338537721246e-05};
            double f = inv_freq[0];
#pragma unroll
            for (int q = 1; q < 8; ++q) f = (i == q) ? inv_freq[q] : f;
            double sn, cs; sincos_d((double)s * f, sn, cs); rope[s * 16 + i] = (float)cs; rope[s * 16 + 8 + i] = (float)sn; }
        for (int e = wg * 512 + tid; e < LRU_W; e += G * 512) { const float lam = in[I_LAM][e]; const float ls = fminf(lam, 0.f) - log1pf(expf(-fabsf(lam))); clam[e] = 8.f * ls * LOG2E; }
        norm_rows<false, false>(in[I_MEM], nullptr, nullptr, nullptr, in[I_MEMNORM], MEMN, nullptr, TM, gw, ngw, lane);
        norm_rows<false, true>(in[I_X], nullptr, nullptr, HB, nullptr, nullptr, RS, T, gw, ngw, lane);
    }
    SYNC(0);
    if (IN(1)) for (int rep = 0; rep < NREP(1); ++rep) {
        { pg8::Gemm g{MEMN, Wmkv, TM, 1024, 1024, 1024, 1024, 0}; pg8::StaticOrder S; S.init(TM, 1024, G, (wg + G / 2) % G); pg8::EpiMkv E{MK, MVT}; pg8::gemm_phase(lds, g, S, E); }
        { pg8::Gemm g{HB, Wina, T, A_IN, 1024, 1024, 1024, 0}; pg8::StaticOrder S; S.init(T, A_IN, G, wg); pg8::EpiProjA E{XRLA, GG, MQ, RS}; pg8::gemm_phase(lds, g, S, E); }
    }
    SYNC(1);
    if (IN(2)) for (int rep = 0; rep < NREP(2); ++rep) {
        PHASE_IDS;
        const float* cw = in[I_CONVW]; const float* cb = in[I_CONVB];
        for (int it = wg * 512 + tid; it < (T / 16) * 96; it += G * 512) {
            const int ch = (it % 96) * 8, rb = (it / 96) * 16;
            float w[4][8], bb[8];
#pragma unroll
            for (int k = 0; k < 4; ++k) { const f32x4 a = *(const f32x4*)(cw + k * LRU_W + ch), b2 = *(const f32x4*)(cw + k * LRU_W + ch + 4);
#pragma unroll
                for (int j = 0; j < 4; ++j) { w[k][j] = a[j]; w[k][4 + j] = b2[j]; } }
            { const f32x4 a = *(const f32x4*)(cb + ch), b2 = *(const f32x4*)(cb + ch + 4);
#pragma unroll
              for (int j = 0; j < 4; ++j) { bb[j] = a[j]; bb[4 + j] = b2[j]; } }
            float xw[4][8];
            const bool head = (rb & (SEQ - 1)) == 0;
#pragma unroll
            for (int q = 0; q < 3; ++q) { u32x4 v = (u32x4){0u, 0u, 0u, 0u}; if (!head) v = *(const u32x4*)(XRLA + (size_t)(rb - 3 + q) * LRU_W + ch);
#pragma unroll
                for (int j = 0; j < 4; ++j) { xw[q][2 * j] = bf_lo(v[j]); xw[q][2 * j + 1] = bf_hi(v[j]); } }
            u32x4 rowv[16];
#pragma unroll
            for (int rr = 0; rr < 16; ++rr) rowv[rr] = *(const u32x4*)(XRLA + (size_t)(rb + rr) * LRU_W + ch);
#pragma unroll
            for (int rr = 0; rr < 16; ++rr) {
                const u32x4 v = rowv[rr]; float o[8];
#pragma unroll
                for (int j = 0; j < 4; ++j) { xw[3][2 * j] = bf_lo(v[j]); xw[3][2 * j + 1] = bf_hi(v[j]); }
#pragma unroll
                for (int j = 0; j < 8; ++j) o[j] = bb[j] + w[0][j] * xw[0][j] + w[1][j] * xw[1][j] + w[2][j] * xw[2][j] + w[3][j] * xw[3][j];
                u32x4 ow; ow.x = cvt_pk_bf16(o[0], o[1]); ow.y = cvt_pk_bf16(o[2], o[3]); ow.z = cvt_pk_bf16(o[4], o[5]); ow.w = cvt_pk_bf16(o[6], o[7]);
                *(u32x4*)(XC + (size_t)(rb + rr) * LRU_W + ch) = ow;
#pragma unroll
                for (int j = 0; j < 8; ++j) { xw[0][j] = xw[1][j]; xw[1][j] = xw[2][j]; xw[2][j] = xw[3][j]; }
            }
        }
        if (G <= BATCH * 24) mem_attn_phase((LAS char*)lds, MQ, 256, 0, MK, MVT, Y, wg, G);
    }
    SYNC(2);
    if (IN(4)) for (int rep = 0; rep < NREP(4); ++rep) {
        PHASE_IDS;
        LAS char* Bl = (LAS char*)lds;
        LAS f32x2* sl = (LAS f32x2*)(lds + 64 * 272);
        const int n32 = lane & 31, hi = lane >> 5;
        const int tau = 16 * ((n32 >> 2) & 1) + (n32 & 3) + 4 * (n32 >> 3);
        if (G > BATCH * 24 && wg >= BATCH * 24) mem_attn_phase((LAS char*)lds, MQ, 256, 0, MK, MVT, Y, wg - BATCH * 24, G - BATCH * 24);
        for (int wgi = wg; wgi < BATCH * 24; wgi += G) {
            const int grp = (wgi & 7) + 8 * (wgi >> 5), q = (wgi >> 3) & 3;
            const int b = grp / 6, hb = grp % 6, c0 = q * 32, ch = hb * 128 + c0 + n32;
            __syncthreads();
            for (int c = tid; c < 64 * 16; c += 512) { const int row = c >> 4, kc = c & 15; const int wrow = (row < 32) ? (c0 + row) : (128 + c0 + row - 32);
                *(LAS u32x4*)(Bl + row * 272 + kc * 16) = *(const u32x4*)(Wg + ((size_t)hb * 256 + wrow) * 128 + kc * 8); }
            const float brv = in[I_BGR][ch], biv = in[I_BGI][ch], clv = clam[ch];
            __syncthreads();
            float hc = 0.f;
            LAS char* At = (LAS char*)lds + 64 * 272 + 16384 + wave * (32 * 272);
            const int lrow = lane >> 4, lcol = lane & 15;
            const bf16_t* xg_u = XC + ((size_t)b * SEQ + wave * 64 + lrow) * LRU_W + hb * 128 + lcol * 8;
            const bf16_t* gp_u = GG + ((size_t)b * SEQ + wave * 64 + 16 * hi) * LRU_W + ch;
            bf16_t* yp_u = Y + ((size_t)b * SEQ + wave * 64 + 16 * hi) * 1024 + ch;
            u32x4 st[2][8];
#pragma unroll
            for (int k = 0; k < 2; ++k)
#pragma unroll
                for (int i = 0; i < 8; ++i) st[k][i] = *(const u32x4*)(xg_u + (size_t)(k * 32 + i * 4) * LRU_W);
            for (int chunk = 0; chunk < 8; ++chunk) {
                float av[2][16], uv[2][16]; unsigned short gr[2][16];
                LAS f32x2* buf = sl + (chunk & 1) * 1024;
                const int cn = (chunk + 1 < 8) ? chunk + 1 : chunk;
#pragma unroll
                for (int k = 0; k < 2; ++k) {
#pragma unroll
                    for (int i = 0; i < 8; ++i) *(LAS u32x4*)(At + (i * 4 + lrow) * 272 + lcol * 16) = st[k][i];
#pragma unroll
                    for (int i = 0; i < 8; ++i) st[k][i] = *(const u32x4*)(xg_u + (size_t)(cn * 512 + k * 32 + i * 4) * LRU_W);
                    asm volatile("s_waitcnt lgkmcnt(0)" ::: "memory");
                    f32x16 accr, acci; const f32x16 z16 = {0.f, 0.f, 0.f, 0.f, 0.f, 0.f, 0.f, 0.f, 0.f, 0.f, 0.f, 0.f, 0.f, 0.f, 0.f, 0.f};
#pragma unroll
                    for (int ks = 0; ks < 8; ++ks) {
                        const bf16x8 afr = *(const LAS bf16x8*)(At + tau * 272 + ks * 32 + hi * 16);
                        const bf16x8 bfr = *(const LAS bf16x8*)(Bl + n32 * 272 + ks * 32 + hi * 16), bfi = *(const LAS bf16x8*)(Bl + (32 + n32) * 272 + ks * 32 + hi * 16);
                        accr = __builtin_amdgcn_mfma_f32_32x32x16_bf16(afr, bfr, ks ? accr : z16, 0, 0, 0);
                        acci = __builtin_amdgcn_mfma_f32_32x32x16_bf16(afr, bfi, ks ? acci : z16, 0, 0, 0);
                    }
                    float P = 1.f, L = 0.f;
#pragma unroll
                    for (int r = 0; r < 16; ++r) {
                        const unsigned short xs = *(const LAS unsigned short*)(At + (16 * hi + r) * 272 + (c0 + n32) * 2);
                        const float rr = sigmoidf_(accr[r] + brv), ii = sigmoidf_(acci[r] + biv);
                        const float a = ex2(rr * clv); float mlt = __builtin_amdgcn_sqrtf(1.f - a * a);
                        if (r == 0 && hi == 0 && k == 0 && chunk == 0 && wave == 0) mlt = 1.f;
                        const float u = mlt * ii * bf_lo((unsigned)xs);
                        av[k][r] = a; uv[k][r] = u;
                        L = a * L + u; P *= a;
                    }
                    buf[(wave * 4 + k * 2 + hi) * 32 + n32] = (f32x2){P, L};
                    asm volatile("s_waitcnt lgkmcnt(0)" ::: "memory");
                }
                __syncthreads();
#pragma unroll
                for (int k = 0; k < 2; ++k)
#pragma unroll
                    for (int r = 0; r < 16; ++r) gr[k][r] = gp_u[(size_t)(chunk * 512 + k * 32 + r) * LRU_W];
                float h = hc, hin0 = 0.f, hin1 = 0.f; const int sg0 = wave * 4 + hi, sg1 = sg0 + 2;
#pragma unroll 8
                for (int s2 = 0; s2 < 32; ++s2) { if (s2 == sg0) hin0 = h; if (s2 == sg1) hin1 = h; const f32x2 e0 = buf[s2 * 32 + n32]; h = e0.x * h + e0.y; }
                hc = h;
#pragma unroll
                for (int k = 0; k < 2; ++k) {
                    float hh = k ? hin1 : hin0;
                    bf16_t* yp = yp_u + (size_t)(chunk * 512 + k * 32) * 1024;
#pragma unroll
                    for (int r = 0; r < 16; ++r) { hh = av[k][r] * hh + uv[k][r]; yp[(size_t)r * 1024] = (bf16_t)(cvt_pk_bf16(hh * bf_lo((unsigned)gr[k][r]), 0.f) & 0xffffu); }
                }
            }
        }
    }
    SYNC(4);
    if (IN(5)) for (int rep = 0; rep < NREP(5); ++rep) { pg8::Gemm g{Y, Wout, T, 1024, 1024, 1024, 1024, 0}; pg8::StaticOrder S; S.init(T, 1024, G, wg); pg8::EpiPlain E{MIXED, 1024}; pg8::gemm_phase(lds, g, S, E); }
    SYNC(5);
    if (IN(6)) for (int rep = 0; rep < NREP(6); ++rep) { PHASE_IDS; norm_rows<true, true>(HB, MIXED, in[I_NMIXPOST], HB, nullptr, nullptr, RS, T, gw, ngw, lane); }
    SYNC(6);
    if (IN(7)) for (int rep = 0; rep < NREP(7); ++rep) { pg8::Gemm g{HB, Wffi, T, 5632, 1024, 1024, 1024, 0}; pg8::StaticOrder S; S.init(T, 5632, G, wg); pg8::EpiSwiglu E{FF, RS}; pg8::gemm_phase(lds, g, S, E); }
    SYNC(7);
    if (IN(8)) for (int rep = 0; rep < NREP(8); ++rep) { pg8::Gemm g{FF, Wffo, T, 1024, DFF, DFF, DFF, 0}; pg8::StaticOrder S; S.init(T, 1024, G, wg); pg8::EpiPlain E{MIXED, 1024}; pg8::gemm_phase(lds, g, S, E); }
    SYNC(8);
    if (IN(9)) for (int rep = 0; rep < NREP(9); ++rep) { PHASE_IDS; norm_rows<true, true>(HB, MIXED, in[I_NFFNPOST], HB, nullptr, nullptr, RS, T, gw, ngw, lane); }
    SYNC(9);
    if (IN(10)) for (int rep = 0; rep < NREP(10); ++rep) { pg8::Gemm g{HB, Wkvq, T, 1536, 1024, 1024, 1024, 0}; pg8::StaticOrder S; S.init(T, 1536, G, wg); pg8::EpiKvq E{KS, VST, Q, rope, RS}; pg8::gemm_phase(lds, g, S, E); }
    SYNC(10);
    if (IN(11)) for (int rep = 0; rep < NREP(11); ++rep) {
        swa_phase((LAS char*)lds, Q, KS, VST, in[I_SINKS], Y1, wg, G);
        mem_attn_phase((LAS char*)lds, Q, 1024, LRU_W, MK + (size_t)TM * 256, MVT + (size_t)TM * 256, Y1, wg, G);
    }
    SYNC(11);
    if (IN(12)) for (int rep = 0; rep < NREP(12); ++rep) { pg8::Gemm g{Y1, Wout + (size_t)1024 * 1024, T, 1024, 1024, 1024, 1024, 0}; pg8::StaticOrder S; S.init(T, 1024, G, wg); pg8::EpiPlain E{MIXED, 1024}; pg8::gemm_phase(lds, g, S, E); }
    SYNC(12);
    if (IN(13)) for (int rep = 0; rep < NREP(13); ++rep) { PHASE_IDS; norm_rows<true, true>(HB, MIXED, in[I_NMIXPOST] + 1024, HB, nullptr, nullptr, RS, T, gw, ngw, lane); }
    SYNC(13);
    if (IN(14)) for (int rep = 0; rep < NREP(14); ++rep) { pg8::Gemm g{HB, Wffi + (size_t)5632 * 1024, T, 5632, 1024, 1024, 1024, 0}; pg8::StaticOrder S; S.init(T, 5632, G, wg); pg8::EpiSwiglu E{FF, RS}; pg8::gemm_phase(lds, g, S, E); }
    SYNC(14);
    if (IN(15)) for (int rep = 0; rep < NREP(15); ++rep) { pg8::Gemm g{FF, Wffo + (size_t)1024 * DFF, T, 1024, DFF, DFF, DFF, 0}; pg8::StaticOrder S; S.init(T, 1024, G, wg); pg8::EpiPlain E{MIXED, 1024}; pg8::gemm_phase(lds, g, S, E); }
    SYNC(15);
    if (IN(16)) for (int rep = 0; rep < NREP(16); ++rep) { PHASE_IDS; norm_rows<true, false>(HB, MIXED, in[I_NFFNPOST] + 1024, H, nullptr, nullptr, nullptr, T, gw, ngw, lane); }
#undef IN
#undef SYNC
}

#undef args
#undef Wmkv
#undef Wina
#undef Wg
#undef Wkvq
#undef Wout
#undef Wffi
#undef Wffo
#undef MEMN
#undef MK
#undef MVT
#undef HN
#undef MIXED
#undef KS
#undef VST
#undef XRLA
#undef XC
#undef GG
#undef GATES
#undef MQ
#undef Y
#undef Y1
#undef HB
#undef RS
#undef Q
#undef FF
#undef rope
#undef clam
#undef H
#undef in
extern "C" void kernel_launch(void* const* d_in, const int* in_sizes, int n_in, void* d_out, int out_size, void* d_ws, size_t ws_size, hipStream_t stream) {
    static int grid = 0;
    if (grid == 0) {
        if (n_in != 23 || in_sizes[0] != T * D || out_size != T * D || ws_size < WS_NEED) { fprintf(stderr, "kernel_launch: unexpected shapes (n_in %d, in0 %d, out %d, ws %zu < %zu)\n", n_in, n_in > 0 ? in_sizes[0] : -1, out_size, ws_size, (size_t)WS_NEED); grid = -1; return; }
        int dev = 0, cus = 0, per_cu = 0;
        (void)hipGetDevice(&dev); (void)hipDeviceGetAttribute(&cus, hipDeviceAttributeMultiprocessorCount, dev);
        if (hipFuncSetAttribute((const void*)fwd_mega, hipFuncAttributeMaxDynamicSharedMemorySize, LDS_BYTES) != hipSuccess) { fprintf(stderr, "kernel_launch: hipFuncSetAttribute failed\n"); grid = -1; return; }
        if (hipOccupancyMaxActiveBlocksPerMultiprocessor(&per_cu, (const void*)fwd_mega, 512, LDS_BYTES) != hipSuccess || per_cu < 1) { fprintf(stderr, "kernel_launch: occupancy query says %d\n", per_cu); per_cu = 1; }
        (void)hipGetLastError();
        grid = cus * per_cu;
        fprintf(stderr, "kernel_launch: grid %d (cus %d x %d)\n", grid, cus, per_cu);
    }
    if (grid < 0) return;
    if (hipMemsetAsync(d_ws, 0, 65536, stream) != hipSuccess) { fprintf(stderr, "kernel_launch: memset failed\n"); return; }
    Args a{};
    for (int i = 0; i < 23; ++i) a.in[i] = (const float*)d_in[i];
    a.out = (float*)d_out; a.ws = (unsigned char*)d_ws; a.pad = 0;
#if MK_MULTI
    for (int ph = 0; ph < NPH; ++ph) { a.ph_lo = ph; a.ph_hi = ph + 1; a.coop = 0; hipLaunchKernelGGL(fwd_mega, dim3(grid), dim3(512), LDS_BYTES, stream, a); }
#else
    a.ph_lo = 0; a.ph_hi = NPH; a.coop = 1;
    void* kargs[] = {&a};
    hipError_t e = hipLaunchCooperativeKernel((const void*)fwd_mega, dim3(grid), dim3(512), kargs, LDS_BYTES, stream);
    if (e != hipSuccess) fprintf(stderr, "kernel_launch: cooperative launch failed: %s (grid %d)\n", hipGetErrorString(e), grid);
#endif
}
```

```cpp
#include <hip/hip_runtime.h>
#include <hip/hip_cooperative_groups.h>
#include <cstdio>
#include <cstdint>
namespace cg = cooperative_groups;

#define LAS __attribute__((address_space(3)))
typedef unsigned short bf16_t;
typedef short bf16x8 __attribute__((ext_vector_type(8)));
typedef short s16x4 __attribute__((ext_vector_type(4)));
typedef float f32x4 __attribute__((ext_vector_type(4)));
typedef float f32x2 __attribute__((ext_vector_type(2)));
typedef float f32x16 __attribute__((ext_vector_type(16)));
typedef unsigned u32x4 __attribute__((ext_vector_type(4)));
typedef unsigned u32x2 __attribute__((ext_vector_type(2)));

#ifndef MK_MULTI
#define MK_MULTI 0
#endif

constexpr int D = 1024, BATCH = 8, SEQ = 4096, T = BATCH * SEQ, NMEM = 256, TM = BATCH * NMEM;
constexpr int LRU_W = 768, MEM_W = 256, DFF = 2816, A_IN = 1792;
constexpr float EPS = 1e-6f;
constexpr float LOG2E = 1.4426950408889634f;
constexpr float QSCALE = 0.125f * LOG2E;

constexpr size_t MiB = 1u << 20;
constexpr size_t al256(size_t x) { return (x + 255) & ~(size_t)255; }
constexpr size_t O_WMKV = 1 * MiB;
constexpr size_t O_WINA = O_WMKV + (size_t)1024 * 1024 * 2;
constexpr size_t O_WG   = O_WINA + (size_t)A_IN * 1024 * 2;
constexpr size_t O_WKVQ = O_WG + (size_t)6 * 256 * 128 * 2;
constexpr size_t O_WOUT = O_WKVQ + (size_t)1536 * 1024 * 2;
constexpr size_t O_WFFI = O_WOUT + (size_t)2 * 1024 * 1024 * 2;
constexpr size_t O_WFFO = O_WFFI + (size_t)2 * 5632 * 1024 * 2;
constexpr size_t O_ROPE = O_WFFO + (size_t)2 * 1024 * DFF * 2;
constexpr size_t O_CLAM = O_ROPE + (size_t)4096 * 16 * 4;
constexpr size_t O_MEMN = al256(O_CLAM + 768 * 4);
constexpr size_t O_MK   = O_MEMN + (size_t)TM * 1024 * 2;
constexpr size_t O_MVT  = O_MK + (size_t)2 * TM * 256 * 2;
constexpr size_t O_RS   = O_MVT + (size_t)2 * TM * 256 * 2;
constexpr size_t O_END_SMALL = O_RS + (size_t)T * 4;
static_assert(O_END_SMALL <= 64 * MiB, "small region");
constexpr size_t O_HN    = 64 * MiB;
constexpr size_t O_MIXED = 128 * MiB;
constexpr size_t O_KS    = 192 * MiB;
constexpr size_t O_VST   = 208 * MiB;
constexpr size_t O_MIX   = 224 * MiB;
constexpr size_t O_XRLA  = O_MIX;
constexpr size_t O_GATES = O_MIX;
constexpr size_t O_XC    = O_MIX + 96 * MiB;
constexpr size_t O_GG    = O_MIX + 144 * MiB;
constexpr size_t O_MQ    = O_MIX + 192 * MiB;
constexpr size_t O_Y     = O_MIX + 208 * MiB;
constexpr size_t O_Q     = O_MIX;
constexpr size_t O_Y1    = O_MIX + 64 * MiB;
constexpr size_t O_HB    = O_HN;
constexpr size_t O_FF    = O_MIX;
constexpr size_t WS_NEED = O_MIX + 272 * MiB;

constexpr int LDS_BYTES = 147456;

__device__ __forceinline__ unsigned cvt_pk_bf16(float lo, float hi) { unsigned r; asm volatile("v_cvt_pk_bf16_f32 %0, %1, %2" : "=v"(r) : "v"(lo), "v"(hi)); return r; }
__device__ __forceinline__ float bf_lo(unsigned w) { return __uint_as_float(w << 16); }
__device__ __forceinline__ float bf_hi(unsigned w) { return __uint_as_float(w & 0xffff0000u); }
__device__ __forceinline__ float ex2(float x) { return __builtin_amdgcn_exp2f(x); }
__device__ __forceinline__ float rcpf_(float x) { return __builtin_amdgcn_rcpf(x); }
__device__ __forceinline__ float sigmoidf_(float x) { return rcpf_(1.f + ex2(-x * LOG2E)); }
__device__ __forceinline__ float gelu_tanh(float x) { const float u = 0.7978845608028654f * (x + 0.044715f * x * x * x); return x * rcpf_(1.f + ex2(-2.f * LOG2E * u)); }
__device__ __forceinline__ float wave_sum(float v) {
#pragma unroll
    for (int o = 1; o < 64; o <<= 1) v += __shfl_xor(v, o);
    return v;
}

namespace pg8 {
constexpr int BM = 256, BK = 64, HALF = 128, HTB = HALF * BK * 2, STAGE_BYTES = 8 * HTB, NXCD = 8, WGM = 8;
__host__ __device__ __forceinline__ int lds_byte(int r, int c) { const int st = (r >> 4) * 2 + (c >> 5), rr = r & 15, cc = c & 31, ob = rr * 64 + cc * 2; return st * 1024 + (ob ^ (((ob >> 9) & 1) << 5)); }
__host__ __device__ __forceinline__ void stage_rc(int b, int& R, int& C) { const int st = b / 1024, sb = b % 1024, swz = sb ^ (((sb >> 9) & 1) << 5); R = (st >> 1) * 16 + swz / 64; C = (st & 1) * 32 + (swz % 64) / 2; }
__host__ __device__ __forceinline__ int perm32(int rho) { const int n = rho >> 4, i = rho & 15; return 8 * (i >> 2) + 4 * n + (i & 3); }

struct Unit { int pm, pn; };
struct Gemm { const bf16_t* A; const bf16_t* Bt; int M, N, K, lda, ldb, a_pn_off; };

struct StaticOrder {
    int nM, nN, nwg, G, c;
    __host__ __device__ void init(int M, int N, int G_, int c_) { nM = M / BM; nN = N / BM; nwg = nM * nN; G = G_; c = c_; }
    __host__ __device__ bool next(int i, Unit& u) const {
        const long L = (long)i * G + c; if (L >= nwg) return false;
        int wgid = (int)L; { const int q = nwg / NXCD, r = nwg % NXCD, xcd = wgid % NXCD, off = wgid / NXCD; wgid = (xcd < r ? xcd * (q + 1) : r * (q + 1) + (xcd - r) * q) + off; }
        const int nig = WGM * nN, gid = wgid / nig, fm = gid * WGM, gsz = (nM - fm) < WGM ? (nM - fm) : WGM;
        u.pm = fm + ((wgid % nig) % gsz); u.pn = (wgid % nig) / gsz; return true;
    }
};

template <class Epi>
__device__ __forceinline__ void gemm_phase(LAS unsigned char* lds, const Gemm g, const StaticOrder& S, const Epi& E) {
    const int tid = threadIdx.x, wid = __builtin_amdgcn_readfirstlane(tid >> 6), lane = tid & 63, wr = wid >> 2, wc = wid & 3, fr = lane & 15, fq = lane >> 4;
    const int K = g.K, nt = K / BK;
    unsigned voffA, voffB;
    { int R, C; stage_rc(tid * 16, R, C); const int Rb = (R & ~31) + perm32(R & 31); voffA = (unsigned)(R * g.lda + C) * 2u; voffB = (unsigned)(Rb * g.ldb + C) * 2u; }
    const unsigned rstepA = 64u * (unsigned)g.lda * 2u, rstepB = 64u * (unsigned)g.ldb * 2u;
    const size_t kstep = (size_t)(BK * 2);
    const size_t hstepA = (size_t)HALF * g.lda * 2, hstepB = (size_t)HALF * g.ldb * 2;
    const size_t tstepA = 2 * hstepA, tstepB = 2 * hstepB;
    const unsigned ldsw = (unsigned)wid * 1024u;
    const int aoff = lds_byte(wr * 64 + fr, fq * 8), boff = lds_byte(wc * 32 + fr, fq * 8);
#define PG8_SA(b, h) (((b) * 2 + (h)) * HTB)
#define PG8_SB(b, h) ((4 + (b) * 2 + (h)) * HTB)
#define PG8_STAGE(bufoff, gbase, voff) do { _Pragma("unroll") for (int _i = 0; _i < 2; ++_i) \
        __builtin_amdgcn_global_load_lds((const unsigned*)((const char*)(gbase) + (size_t)_i * PG8_RSTEP_##voff + voff), (LAS unsigned*)(lds + (bufoff) + ldsw + _i * 8192), 16, 0, 0); } while (0)
#define PG8_RSTEP_voffA rstepA
#define PG8_RSTEP_voffB rstepB
#define PG8_LDA(dst, b, h) do { _Pragma("unroll") for (int m = 0; m < 4; ++m) _Pragma("unroll") for (int k = 0; k < 2; ++k) dst[m][k] = *(const LAS bf16x8*)(lds + PG8_SA(b, h) + aoff + m * 2048 + k * 1024); } while (0)
#define PG8_LDB(dst, b, h) do { _Pragma("unroll") for (int n = 0; n < 2; ++n) _Pragma("unroll") for (int k = 0; k < 2; ++k) dst[n][k] = *(const LAS bf16x8*)(lds + PG8_SB(b, h) + boff + n * 2048 + k * 1024); } while (0)
#define PG8_MMA(ai, bj, At, Bt) do { __builtin_amdgcn_s_setprio(1); _Pragma("unroll") for (int m = 0; m < 4; ++m) _Pragma("unroll") for (int n = 0; n < 2; ++n) _Pragma("unroll") for (int k = 0; k < 2; ++k) \
        acc[ai][bj][m][n] = __builtin_amdgcn_mfma_f32_16x16x32_bf16(Bt[n][k], At[m][k], acc[ai][bj][m][n], 0, 0, 0); __builtin_amdgcn_s_setprio(0); } while (0)
#define PG8_MMA0(ai, bj, At, Bt) do { __builtin_amdgcn_s_setprio(1); _Pragma("unroll") for (int m = 0; m < 4; ++m) _Pragma("unroll") for (int n = 0; n < 2; ++n) { \
        acc[ai][bj][m][n] = __builtin_amdgcn_mfma_f32_16x16x32_bf16(Bt[n][0], At[m][0], (f32x4){0.f, 0.f, 0.f, 0.f}, 0, 0, 0); \
        acc[ai][bj][m][n] = __builtin_amdgcn_mfma_f32_16x16x32_bf16(Bt[n][1], At[m][1], acc[ai][bj][m][n], 0, 0, 0); } __builtin_amdgcn_s_setprio(0); } while (0)
#define PG8_WAIT_V(n) asm volatile("s_waitcnt vmcnt(" #n ")" ::: "memory")
#define PG8_WAIT_L(n) asm volatile("s_waitcnt lgkmcnt(" #n ")" ::: "memory")
#define PG8_BAR __builtin_amdgcn_s_barrier()
#define PG8_SCHED __builtin_amdgcn_sched_barrier(0)
    Unit cur, nxt; int ui = 0;
    if (!S.next(0, cur)) return;
    f32x4 acc[2][2][4][2];
    bf16x8 At[4][2], B0[2][2], B1[2][2];
    const char* cA = (const char*)g.A + (size_t)cur.pm * tstepA + (size_t)cur.pn * g.a_pn_off * 2; const char* cB = (const char*)g.Bt + (size_t)cur.pn * tstepB;
    PG8_STAGE(PG8_SB(0, 0), cB, voffB); PG8_STAGE(PG8_SB(0, 1), cB + hstepB, voffB); PG8_STAGE(PG8_SA(0, 0), cA, voffA); PG8_STAGE(PG8_SA(0, 1), cA + hstepA, voffA);
    if (wr == 1) PG8_BAR;
    PG8_WAIT_V(2); PG8_BAR;
    PG8_STAGE(PG8_SB(1, 0), cB + kstep, voffB); PG8_STAGE(PG8_SA(1, 0), cA + kstep, voffA); PG8_STAGE(PG8_SB(1, 1), cB + hstepB + kstep, voffB);
    PG8_WAIT_V(6); PG8_BAR;
    for (;;) {
        const bool has_next = S.next(ui + 1, nxt);
        const char* nA = has_next ? (const char*)g.A + (size_t)nxt.pm * tstepA + (size_t)nxt.pn * g.a_pn_off * 2 : cA; const char* nB = has_next ? (const char*)g.Bt + (size_t)nxt.pn * tstepB : cB;
        float pre[8]; E.prefetch(pre, cur, wr, fr);
        for (int t = 0; t < nt; t += 2) {
            const bool last = (t == nt - 2);
            const char* a1 = cA + (size_t)(t + 1) * kstep;
            const char* a2 = last ? nA : cA + (size_t)(t + 2) * kstep; const char* b2 = last ? nB : cB + (size_t)(t + 2) * kstep;
            const char* a3 = a2 + kstep; const char* b3 = b2 + kstep;
            PG8_LDB(B0, 0, 0); PG8_LDB(B1, 0, 1); PG8_SCHED; PG8_LDA(At, 0, 0); PG8_STAGE(PG8_SA(1, 1), a1 + hstepA, voffA);
            PG8_WAIT_V(8); PG8_WAIT_L(0); PG8_BAR; if (t == 0) { PG8_MMA0(0, 0, At, B0); PG8_MMA0(0, 1, At, B1); } else { PG8_MMA(0, 0, At, B0); PG8_MMA(0, 1, At, B1); } PG8_BAR; PG8_SCHED;
            PG8_LDA(At, 0, 1); PG8_STAGE(PG8_SB(0, 0), b2, voffB); PG8_STAGE(PG8_SB(0, 1), b2 + hstepB, voffB); PG8_STAGE(PG8_SA(0, 0), a2, voffA);
            PG8_WAIT_V(8); PG8_WAIT_L(0); PG8_BAR; if (t == 0) { PG8_MMA0(1, 0, At, B0); PG8_MMA0(1, 1, At, B1); } else { PG8_MMA(1, 0, At, B0); PG8_MMA(1, 1, At, B1); } PG8_BAR; PG8_SCHED;
            PG8_LDB(B0, 1, 0); PG8_LDB(B1, 1, 1); PG8_SCHED; PG8_LDA(At, 1, 0); PG8_STAGE(PG8_SA(0, 1), a2 + hstepA, voffA);
            PG8_WAIT_V(8); PG8_WAIT_L(0); PG8_BAR; PG8_MMA(0, 0, At, B0); PG8_MMA(0, 1, At, B1); PG8_BAR; PG8_SCHED;
            PG8_LDA(At, 1, 1); PG8_STAGE(PG8_SB(1, 0), b3, voffB); PG8_STAGE(PG8_SB(1, 1), b3 + hstepB, voffB); PG8_STAGE(PG8_SA(1, 0), a3, voffA);
            PG8_WAIT_V(8); PG8_WAIT_L(0); PG8_BAR; PG8_MMA(1, 0, At, B0); PG8_MMA(1, 1, At, B1); PG8_BAR; PG8_SCHED;
        }
        if (wr == 0) PG8_BAR;
        E(acc, cur, wr, wc, fr, fq, pre);
        if (!has_next) break;
        cur = nxt; cA = nA; cB = nB; ++ui;
        if (wr == 1) PG8_BAR;
    }
    PG8_WAIT_V(0);
    PG8_BAR;
#undef PG8_SA
#undef PG8_SB
#undef PG8_STAGE
#undef PG8_RSTEP_voffA
#undef PG8_RSTEP_voffB
#undef PG8_LDA
#undef PG8_LDB
#undef PG8_MMA
#undef PG8_MMA0
#undef PG8_WAIT_V
#undef PG8_WAIT_L
#undef PG8_BAR
#undef PG8_SCHED
}

typedef f32x4 Acc[2][2][4][2];
__device__ __forceinline__ void store8(bf16_t* p, f32x4 v0, f32x4 v1) {
    u32x4 w; w.x = cvt_pk_bf16(v0[0], v0[1]); w.y = cvt_pk_bf16(v0[2], v0[3]); w.z = cvt_pk_bf16(v1[0], v1[1]); w.w = cvt_pk_bf16(v1[2], v1[3]);
    *(u32x4*)p = w;
}

struct EpiPlain {
    bf16_t* O; int ldc;
    __device__ __forceinline__ void prefetch(float (&pre)[8], const Unit&, int, int) const {}
    __device__ __forceinline__ void operator()(const Acc& acc, const Unit& u, int wr, int wc, int fr_in, int fq_in, const float (&pre)[8]) const {
        int fr = fr_in, fq = fq_in; asm volatile("" : "+v"(fr), "+v"(fq));
        const int row0 = u.pm * BM + wr * 64 + fr, col0 = u.pn * BM + wc * 32 + 8 * fq;
#pragma unroll
        for (int ai = 0; ai < 2; ++ai)
#pragma unroll
            for (int m = 0; m < 4; ++m) { bf16_t* rowp = O + (size_t)(row0 + ai * HALF + m * 16) * ldc + col0;
#pragma unroll
                for (int bj = 0; bj < 2; ++bj) store8(rowp + bj * HALF, acc[ai][bj][m][0], acc[ai][bj][m][1]); }
    }
};
struct EpiProjA {
    bf16_t *XR, *GG, *MQ; const float* rs;
    __device__ __forceinline__ void prefetch(float (&pre)[8], const Unit&, int, int) const {}
    __device__ __forceinline__ void operator()(const Acc& acc, const Unit& u, int wr, int wc, int fr_in, int fq_in, const float (&pre)[8]) const {
        int fr = fr_in, fq = fq_in; asm volatile("" : "+v"(fr), "+v"(fq));
        const int pn = u.pn; bf16_t* base; int ld, colt, mode;
        if (pn < 3) { base = XR; ld = LRU_W; colt = pn * 256; mode = 0; } else if (pn < 6) { base = GG; ld = LRU_W; colt = (pn - 3) * 256; mode = 1; } else { base = MQ; ld = MEM_W; colt = 0; mode = 2; }
        const int row0 = u.pm * BM + wr * 64 + fr, col0 = colt + wc * 32 + 8 * fq;
        float rloc[8];
#pragma unroll
        for (int q = 0; q < 8; ++q) rloc[q] = rs[row0 + (q >> 2) * HALF + (q & 3) * 16];
#pragma unroll
        for (int ai = 0; ai < 2; ++ai)
#pragma unroll
            for (int m = 0; m < 4; ++m) { bf16_t* rowp = base + (size_t)(row0 + ai * HALF + m * 16) * ld + col0; const float rsv = rloc[ai * 4 + m];
#pragma unroll
                for (int bj = 0; bj < 2; ++bj) { f32x4 v0 = acc[ai][bj][m][0] * rsv, v1 = acc[ai][bj][m][1] * rsv;
                    if (mode == 1) {
#pragma unroll
                        for (int j = 0; j < 4; ++j) { v0[j] = gelu_tanh(v0[j]); v1[j] = gelu_tanh(v1[j]); } }
                    else if (mode == 2) { v0 = v0 * QSCALE; v1 = v1 * QSCALE; }
                    store8(rowp + bj * HALF, v0, v1); } }
    }
};
struct EpiMkv {
    bf16_t *MK, *MVT;
    __device__ __forceinline__ void prefetch(float (&pre)[8], const Unit&, int, int) const {}
    __device__ __forceinline__ void operator()(const Acc& acc, const Unit& u, int wr, int wc, int fr_in, int fq_in, const float (&pre)[8]) const {
        int fr = fr_in, fq = fq_in; asm volatile("" : "+v"(fr), "+v"(fq));
        const int l = u.pn >> 1;
        if ((u.pn & 1) == 0) {
            bf16_t* O = MK + (size_t)l * TM * 256; const int row0 = u.pm * BM + wr * 64 + fr, col0 = wc * 32 + 8 * fq;
#pragma unroll
            for (int ai = 0; ai < 2; ++ai)
#pragma unroll
                for (int m = 0; m < 4; ++m) { bf16_t* rowp = O + (size_t)(row0 + ai * HALF + m * 16) * 256 + col0;
#pragma unroll
                    for (int bj = 0; bj < 2; ++bj) store8(rowp + bj * HALF, acc[ai][bj][m][0], acc[ai][bj][m][1]); }
        } else {
            bf16_t* O = MVT + (size_t)l * TM * 256 + (size_t)u.pm * 256 * 256;
#pragma unroll
            for (int ai = 0; ai < 2; ++ai)
#pragma unroll
                for (int m = 0; m < 4; ++m) { const int mi = ai * HALF + wr * 64 + m * 16 + fr;
#pragma unroll
                    for (int bj = 0; bj < 2; ++bj)
#pragma unroll
                        for (int n = 0; n < 2; ++n)
#pragma unroll
                            for (int j = 0; j < 4; ++j) { const int c = bj * HALF + wc * 32 + 8 * fq + 4 * n + j; O[(size_t)c * 256 + mi] = (bf16_t)(cvt_pk_bf16(acc[ai][bj][m][n][j], 0.f) & 0xffffu); } }
        }
    }
};
struct EpiSwiglu {
    bf16_t* O; const float* rs;
    __device__ __forceinline__ void prefetch(float (&pre)[8], const Unit& u, int wr, int fr) const {
#pragma unroll
        for (int q = 0; q < 8; ++q) pre[q] = rs[u.pm * BM + wr * 64 + fr + (q >> 2) * HALF + (q & 3) * 16]; }
    __device__ __forceinline__ void operator()(const Acc& acc, const Unit& u, int wr, int wc, int fr_in, int fq_in, const float (&pre)[8]) const {
        int fr = fr_in, fq = fq_in; asm volatile("" : "+v"(fr), "+v"(fq));
        const int row0 = u.pm * BM + wr * 64 + fr, col0 = u.pn * HALF + wc * 32 + 8 * fq;
#pragma unroll
        for (int ai = 0; ai < 2; ++ai)
#pragma unroll
            for (int m = 0; m < 4; ++m) { bf16_t* rowp = O + (size_t)(row0 + ai * HALF + m * 16) * DFF + col0; const float rsv = pre[ai * 4 + m];
                f32x4 o[2]; const float c1 = -rsv * LOG2E, c2 = rsv * rsv;
#pragma unroll
                for (int n = 0; n < 2; ++n) { const f32x4 g4 = acc[ai][0][m][n], u4 = acc[ai][1][m][n]; const f32x4 t4 = g4 * c1; f32x4 d4;
#pragma unroll
                    for (int j = 0; j < 4; ++j) d4[j] = ex2(t4[j]);
                    d4 = d4 + 1.0f; f32x4 q4;
#pragma unroll
                    for (int j = 0; j < 4; ++j) q4[j] = rcpf_(d4[j]);
                    o[n] = ((g4 * u4) * c2) * q4; }
                store8(rowp, o[0], o[1]); }
    }
};
struct EpiKvq {
    bf16_t *KS, *VST, *Q; const float* rope; const float* rs;
    __device__ __forceinline__ void prefetch(float (&pre)[8], const Unit&, int, int) const {}
    __device__ __forceinline__ void operator()(const Acc& acc, const Unit& u, int wr, int wc, int fr_in, int fq_in, const float (&pre)[8]) const {
        int fr = fr_in, fq = fq_in; asm volatile("" : "+v"(fr), "+v"(fq));
        const int pn = u.pn;
        if (pn == 1) {
#pragma unroll
            for (int ai = 0; ai < 2; ++ai)
#pragma unroll
                for (int m = 0; m < 4; ++m) { const int row = u.pm * BM + ai * HALF + wr * 64 + m * 16 + fr; const int b = row >> 12, s = row & (SEQ - 1); const float rsv = rs[row];
                    bf16_t* O = VST + (size_t)b * 256 * SEQ + s;
#pragma unroll
                    for (int bj = 0; bj < 2; ++bj)
#pragma unroll
                        for (int n = 0; n < 2; ++n)
#pragma unroll
                            for (int j = 0; j < 4; ++j) { const int c = bj * HALF + wc * 32 + 8 * fq + 4 * n + j; O[(size_t)c * SEQ] = (bf16_t)(cvt_pk_bf16(acc[ai][bj][m][n][j] * rsv, 0.f) & 0xffffu); }
                    __builtin_amdgcn_sched_barrier(0); }
            return;
        }
        bf16_t* base; int ld, colt; float sc; bool do_rope;
        if (pn == 0) { base = KS; ld = 256; colt = 0; sc = 1.f; do_rope = true; }
        else { base = Q; ld = 1024; colt = (pn - 2) * 256; sc = QSCALE; do_rope = (pn < 5); }
        const int row0 = u.pm * BM + wr * 64 + fr, col0 = colt + wc * 32 + 8 * fq;
        const bool rot_lane = do_rope && ((wc & 1) == 0) && (fq < 2);
        const float sgn = (fq == 0) ? -1.f : 1.f;
#pragma unroll
        for (int ai = 0; ai < 2; ++ai)
#pragma unroll
            for (int m = 0; m < 4; ++m) { const int row = row0 + ai * HALF + m * 16; bf16_t* rowp = base + (size_t)row * ld + col0;
                const float* rp = rope + (size_t)(row & (SEQ - 1)) * 16; const float rsc = rs[row] * sc;
#pragma unroll
                for (int n = 0; n < 2; ++n) { const f32x4 cs = *(const f32x4*)(rp + 4 * n), sn = *(const f32x4*)(rp + 8 + 4 * n);
#pragma unroll
                    for (int bj = 0; bj < 2; ++bj) { float v[4];
#pragma unroll
                        for (int j = 0; j < 4; ++j) { const float x = acc[ai][bj][m][n][j]; const float pr = __shfl_xor(x, 16);
                            float o = x; if (rot_lane) o = x * cs[j] + sgn * pr * sn[j];
                            v[j] = o * rsc; }
                        u32x2 w; w.x = cvt_pk_bf16(v[0], v[1]); w.y = cvt_pk_bf16(v[2], v[3]); *(u32x2*)(rowp + bj * HALF + 4 * n) = w; }
                    __builtin_amdgcn_sched_barrier(0); }
                }
    }
};
}

constexpr int KPITCH = 144;
__device__ __forceinline__ void load_q(bf16x8 (&qr)[4], const bf16_t* Qp, int ldq, int lane) {
#pragma unroll
    for (int d0 = 0; d0 < 4; ++d0) qr[d0] = *(const bf16x8*)(Qp + (size_t)(lane & 31) * ldq + d0 * 16 + (lane >> 5) * 8);
}
template <int NKB, bool SWA>
__device__ __forceinline__ void attn_task(bf16x8 (&qr)[4], const bf16_t* Qnext, int ldq, const LAS char* Kl, const LAS char* Vl, int vpitch, int key0,
                                          bf16_t* Op, int ldo, float sink2, bool has_prev, int ci0  , int lane) {
    const int r32 = lane & 31, hi = lane >> 5;
    f32x16 p[NKB];
#pragma unroll
    for (int kb = 0; kb < NKB; ++kb) {
        const LAS char* kp = Kl + (key0 + 32 * kb + r32) * KPITCH + hi * 16;
        const f32x16 z16 = {0.f, 0.f, 0.f, 0.f, 0.f, 0.f, 0.f, 0.f, 0.f, 0.f, 0.f, 0.f, 0.f, 0.f, 0.f, 0.f};
#pragma unroll
        for (int d0 = 0; d0 < 4; ++d0) { const bf16x8 a = *(const LAS bf16x8*)(kp + d0 * 32); p[kb] = __builtin_amdgcn_mfma_f32_32x32x16_bf16(a, qr[d0], d0 ? p[kb] : z16, 0, 0, 0); }
    }
    float m = -INFINITY;
    if (SWA) {
#pragma unroll
        for (int kb = 0; kb < NKB; ++kb)
#pragma unroll
            for (int r = 0; r < 16; ++r) { const int cr = (r & 3) + 8 * (r >> 2) + 4 * hi; const int rel = 32 * kb + cr - r32;
                const int kwin = ci0 + 32 * kb + cr;
                const bool ok = (rel >= 1) && (rel <= 128) && (has_prev || kwin >= 128);
                if (!ok) p[kb][r] = -INFINITY; m = fmaxf(m, p[kb][r]); }
    } else {
#pragma unroll
        for (int kb = 0; kb < NKB; ++kb)
#pragma unroll
            for (int r = 0; r < 16; ++r) m = fmaxf(m, p[kb][r]);
    }
    m = fmaxf(m, __shfl_xor(m, 32));
    if (SWA) m = fmaxf(m, sink2);
    float sum = 0.f;
#pragma unroll
    for (int kb = 0; kb < NKB; ++kb)
#pragma unroll
        for (int r = 0; r < 16; ++r) { const float e = ex2(p[kb][r] - m); p[kb][r] = e; sum += e; }
    sum += __shfl_xor(sum, 32);
    if (SWA) sum += ex2(sink2 - m);
    const float inv = 1.f / sum;
    f32x16 o[2]; const f32x16 zo16 = {0.f, 0.f, 0.f, 0.f, 0.f, 0.f, 0.f, 0.f, 0.f, 0.f, 0.f, 0.f, 0.f, 0.f, 0.f, 0.f};
#pragma unroll
    for (int kb = 0; kb < NKB; ++kb)
#pragma unroll
        for (int ks = 0; ks < 2; ++ks) {
            u32x4 pw; pw.x = cvt_pk_bf16(p[kb][8 * ks + 0], p[kb][8 * ks + 1]); pw.y = cvt_pk_bf16(p[kb][8 * ks + 2], p[kb][8 * ks + 3]);
            pw.z = cvt_pk_bf16(p[kb][8 * ks + 4], p[kb][8 * ks + 5]); pw.w = cvt_pk_bf16(p[kb][8 * ks + 6], p[kb][8 * ks + 7]);
            const bf16x8 pf = __builtin_bit_cast(bf16x8, pw);
            const int kbase = key0 + 32 * kb + 16 * ks + 4 * hi;
#pragma unroll
            for (int nb = 0; nb < 2; ++nb) { const LAS char* vp = Vl + (32 * nb + r32) * vpitch + kbase * 2;
                const s16x4 lo = *(const LAS s16x4*)vp, hh = *(const LAS s16x4*)(vp + 16);
                const bf16x8 vf = (bf16x8){lo[0], lo[1], lo[2], lo[3], hh[0], hh[1], hh[2], hh[3]};
                o[nb] = __builtin_amdgcn_mfma_f32_32x32x16_bf16(vf, pf, (kb | ks) ? o[nb] : zo16, 0, 0, 0); }
        }
#pragma unroll
    for (int d0 = 0; d0 < 4; ++d0) qr[d0] = *(const bf16x8*)(Qnext + (size_t)r32 * ldq + d0 * 16 + hi * 8);
    bf16_t* orow = Op + (size_t)r32 * ldo;
#pragma unroll
    for (int nb = 0; nb < 2; ++nb)
#pragma unroll
        for (int g4 = 0; g4 < 4; ++g4) { u32x2 w; w.x = cvt_pk_bf16(o[nb][4 * g4 + 0] * inv, o[nb][4 * g4 + 1] * inv); w.y = cvt_pk_bf16(o[nb][4 * g4 + 2] * inv, o[nb][4 * g4 + 3] * inv);
            *(u32x2*)(orow + 32 * nb + 8 * g4 + 4 * hi) = w; }
}

__device__ __forceinline__ void load_k_tile(LAS char* Kl, const bf16_t* src, int gp, int nrows, int zero_rows, int tid) {
    for (int c = tid; c < nrows * 8; c += 512) { const int r = c >> 3, ch = c & 7; u32x4 v = (u32x4){0u, 0u, 0u, 0u};
        if (r >= zero_rows) v = *(const u32x4*)(src + (ptrdiff_t)r * gp + ch * 8);
        *(LAS u32x4*)(Kl + r * KPITCH + ch * 16) = v; }
}
__device__ __forceinline__ void load_vt_tile(LAS char* Vl, int vpitch, const bf16_t* src, int gp, int nkeys, int zero_keys, int tid) {
    const int cpr = nkeys >> 3;
    for (int c = tid; c < 64 * cpr; c += 512) { const int d = c / cpr, ch = c - d * cpr; u32x4 v = (u32x4){0u, 0u, 0u, 0u};
        if (ch * 8 >= zero_keys) v = *(const u32x4*)(src + (ptrdiff_t)d * gp + ch * 8);
        LAS char* dst = Vl + d * vpitch + ch * 16; *(LAS u32x2*)dst = (u32x2){v.x, v.y}; *(LAS u32x2*)(dst + 8) = (u32x2){v.z, v.w}; }
}

__device__ __forceinline__ const bf16_t* mem_qptr(const bf16_t* Qb, int ldq, int qcol0, int unit, int wid) {
    const int b = unit >> 6, h = (unit >> 4) & 3, c = unit & 15; return Qb + ((size_t)b * SEQ + c * 256 + wid * 32) * ldq + qcol0 + h * 64; }
__device__ __forceinline__ void mem_attn_phase(LAS char* lds, const bf16_t* Qb, int ldq, int qcol0, const bf16_t* MK, const bf16_t* MVT, bf16_t* Y, int wg, int nwg) {
    const int tid = threadIdx.x, wid = tid >> 6, lane = tid & 63;
    LAS char* Kl = lds; LAS char* Vl = lds + 256 * KPITCH; constexpr int VP = 520; constexpr int NU = BATCH * 4 * 16;
    bf16x8 qr[4];
    if (wg < NU) load_q(qr, mem_qptr(Qb, ldq, qcol0, wg, wid), ldq, lane);
    for (int unit = wg; unit < NU; unit += nwg) {
        const int b = unit >> 6, h = (unit >> 4) & 3, c = unit & 15;
        load_k_tile(Kl, MK + (size_t)b * NMEM * 256 + h * 64, 256, 256, 0, tid);
        load_vt_tile(Vl, VP, MVT + ((size_t)b * 256 + h * 64) * 256, 256, 256, 0, tid);
        __syncthreads();
        const size_t row = (size_t)b * SEQ + c * 256 + wid * 32;
        const int nu = (unit + nwg < NU) ? unit + nwg : unit;
        attn_task<8, false>(qr, mem_qptr(Qb, ldq, qcol0, nu, wid), ldq, Kl, Vl, VP, 0, Y + row * 1024 + LRU_W + h * 64, 1024, 0.f, true, 0, lane);
        __syncthreads();
    }
}
__device__ __forceinline__ const bf16_t* swa_qptr(const bf16_t* Q, int unit, int task) {
    const int b = unit >> 6, np = (unit >> 2) & 15, kh = unit & 3; const int blk = task / 12, rem = task - blk * 12, g = rem >> 2, j = rem & 3;
    return Q + ((size_t)b * SEQ + (2 * np + blk) * 128 + j * 32) * 1024 + (kh * 3 + g) * 64; }
__device__ __forceinline__ void swa_phase(LAS char* lds, const bf16_t* Q, const bf16_t* KS, const bf16_t* VST, const float* sinks, bf16_t* Y, int wg, int nwg) {
    const int tid = threadIdx.x, wid = tid >> 6, lane = tid & 63;
    LAS char* Kl = lds; LAS char* Vl = lds + 384 * KPITCH; constexpr int VP = 776; constexpr int NU = BATCH * 16 * 4;
    bf16x8 qr[4];
    if (wg < NU) load_q(qr, swa_qptr(Q, wg, wid), 1024, lane);
    for (int unit = wg; unit < NU; unit += nwg) {
        const int b = unit >> 6, np = (unit >> 2) & 15, kh = unit & 3;
        const int s0 = (2 * np - 1) * 128;
        const int zk = (np == 0) ? 128 : 0;
        load_k_tile(Kl, KS + ((ptrdiff_t)b * SEQ + s0) * 256 + kh * 64, 256, 384, zk, tid);
        load_vt_tile(Vl, VP, VST + ((ptrdiff_t)b * 256 + kh * 64) * SEQ + s0, SEQ, 384, zk, tid);
        __syncthreads();
#pragma unroll 1
        for (int task = wid; task < 24; task += 8) {
            const int blk = task / 12, rem = task - blk * 12, g = rem >> 2, j = rem & 3;
            const int head = kh * 3 + g;
            const size_t row = (size_t)b * SEQ + (2 * np + blk) * 128 + j * 32;
            const float sink2 = sinks[head] * LOG2E;
            const bf16_t* qn = (task + 8 < 24) ? swa_qptr(Q, unit, task + 8) : swa_qptr(Q, (unit + nwg < NU) ? unit + nwg : unit, wid);
            attn_task<5, true>(qr, qn, 1024, Kl, Vl, VP, 128 * blk + 32 * j, Y + row * 1024 + head * 64, 1024, sink2, (2 * np + blk) > 0, 32 * j, lane);
        }
        __syncthreads();
    }
}

struct RowPair { f32x4 v[2][4]; u32x2 mw[2][4]; int rows[2]; };
template <bool IN_BF>
__device__ __forceinline__ void rp_load(RowPair& P, const void* hin_, const bf16_t* mixed, int row, int ngw, int nrows, int lane) {
    P.rows[0] = row; P.rows[1] = (row + ngw < nrows) ? row + ngw : row;
#pragma unroll
    for (int q = 0; q < 2; ++q) {
        if (IN_BF) { const u32x2* hr = (const u32x2*)((const bf16_t*)hin_ + (size_t)P.rows[q] * D) + lane;
#pragma unroll
            for (int j = 0; j < 4; ++j) { const u32x2 w = hr[64 * j]; P.v[q][j] = (f32x4){__uint_as_float(w.x), __uint_as_float(w.y), 0.f, 0.f}; } }
        else { const f32x4* hr = (const f32x4*)((const float*)hin_ + (size_t)P.rows[q] * D) + lane;
#pragma unroll
            for (int j = 0; j < 4; ++j) P.v[q][j] = hr[64 * j]; }
        if (mixed) { const u32x2* mr = (const u32x2*)(mixed + (size_t)P.rows[q] * D) + lane;
#pragma unroll
            for (int j = 0; j < 4; ++j) P.mw[q][j] = mr[64 * j]; }
    }
}
template <bool IN_BF, bool OUT_BF>
__device__ __forceinline__ void rp_proc(RowPair& P, const bf16_t* mixed, const float* g_post, void* hout_, const float* g_next, bf16_t* HNo, float* RSo, int lane) {
#pragma unroll
    for (int q = 0; q < 2; ++q) {
        f32x4 v[4];
#pragma unroll
        for (int j = 0; j < 4; ++j) { if (IN_BF) { const unsigned wx = __float_as_uint(P.v[q][j][0]), wy = __float_as_uint(P.v[q][j][1]); v[j] = (f32x4){bf_lo(wx), bf_hi(wx), bf_lo(wy), bf_hi(wy)}; } else v[j] = P.v[q][j]; }
        if (mixed) { f32x4 mv[4]; float s = 0.f;
#pragma unroll
            for (int j = 0; j < 4; ++j) { const u32x2 w = P.mw[q][j]; mv[j] = (f32x4){bf_lo(w.x), bf_hi(w.x), bf_lo(w.y), bf_hi(w.y)}; s += (mv[j][0] * mv[j][0] + mv[j][1] * mv[j][1]) + (mv[j][2] * mv[j][2] + mv[j][3] * mv[j][3]); }
            const float rstd = 1.f / __builtin_sqrtf(wave_sum(s) * (1.f / D) + EPS);
#pragma unroll
            for (int j = 0; j < 4; ++j) { const f32x4 gp = *((const f32x4*)g_post + lane + 64 * j); v[j] = v[j] + mv[j] * rstd * gp; } }
        if (hout_) {
            if (OUT_BF) { u32x2* ho = (u32x2*)((bf16_t*)hout_ + (size_t)P.rows[q] * D) + lane;
#pragma unroll
                for (int j = 0; j < 4; ++j) { u32x2 w; w.x = cvt_pk_bf16(v[j][0], v[j][1]); w.y = cvt_pk_bf16(v[j][2], v[j][3]); ho[64 * j] = w; } }
            else { f32x4* ho = (f32x4*)((float*)hout_ + (size_t)P.rows[q] * D) + lane;
#pragma unroll
                for (int j = 0; j < 4; ++j) ho[64 * j] = v[j]; } }
        if (HNo || RSo) { float s = 0.f;
#pragma unroll
            for (int j = 0; j < 4; ++j) s += (v[j][0] * v[j][0] + v[j][1] * v[j][1]) + (v[j][2] * v[j][2] + v[j][3] * v[j][3]);
            const float rstd = 1.f / __builtin_sqrtf(wave_sum(s) * (1.f / D) + EPS);
            if (RSo) { if (lane == 0) RSo[P.rows[q]] = rstd; }
            else { u32x2* o8 = (u32x2*)(HNo + (size_t)P.rows[q] * D) + lane;
#pragma unroll
                for (int j = 0; j < 4; ++j) { f32x4 gn = (f32x4){1.f, 1.f, 1.f, 1.f}; if (g_next) gn = *((const f32x4*)g_next + lane + 64 * j); const f32x4 o = v[j] * rstd * gn;
                    u32x2 w; w.x = cvt_pk_bf16(o[0], o[1]); w.y = cvt_pk_bf16(o[2], o[3]); o8[64 * j] = w; } } }
    }
}
template <bool IN_BF, bool OUT_BF>
__device__ __forceinline__ void norm_rows(const void* hin_, const bf16_t* mixed, const float* g_post, void* hout_, const float* g_next, bf16_t* HNo, float* RSo, int nrows, int gw, int ngw, int lane) {
    const int step = 2 * ngw;
    if (gw >= nrows) return;
    RowPair A, B;
    rp_load<IN_BF>(A, hin_, mixed, gw, ngw, nrows, lane);
    for (int row = gw; row < nrows; row += 2 * step) {
        const bool hasB = row + step < nrows, hasA2 = row + 2 * step < nrows;
        if (hasB) rp_load<IN_BF>(B, hin_, mixed, row + step, ngw, nrows, lane);
        rp_proc<IN_BF, OUT_BF>(A, mixed, g_post, hout_, g_next, HNo, RSo, lane);
        if (hasA2) rp_load<IN_BF>(A, hin_, mixed, row + 2 * step, ngw, nrows, lane);
        if (hasB) rp_proc<IN_BF, OUT_BF>(B, mixed, g_post, hout_, g_next, HNo, RSo, lane);
    }
}
__device__ __forceinline__ void tr_item(const float* W, int ldw, int k0, int n0, bf16_t* WT, int ldt, int dst_row0, const float* gk, LAS float* scr, int lane) {
    float wv[32];
#pragma unroll
    for (int i = 0; i < 32; ++i) { const int kk = 2 * i + (lane >> 5); wv[i] = W[(size_t)(k0 + kk) * ldw + n0 + (lane & 31)]; }
#pragma unroll
    for (int i = 0; i < 32; ++i) { const int kk = 2 * i + (lane >> 5); float w = wv[i]; if (gk) w *= gk[k0 + kk]; scr[kk * 33 + (lane & 31)] = w; }
    asm volatile("s_waitcnt lgkmcnt(0)" ::: "memory");
    const int c = lane & 7;
#pragma unroll
    for (int j = 0; j < 4; ++j) { const int n = (lane >> 3) + 8 * j; const LAS float* s = scr + (8 * c) * 33 + n;
        u32x4 o; o.x = cvt_pk_bf16(s[0 * 33], s[1 * 33]); o.y = cvt_pk_bf16(s[2 * 33], s[3 * 33]); o.z = cvt_pk_bf16(s[4 * 33], s[5 * 33]); o.w = cvt_pk_bf16(s[6 * 33], s[7 * 33]);
        *(u32x4*)(WT + (size_t)(dst_row0 + n) * ldt + k0 + 8 * c) = o; }
    asm volatile("s_waitcnt lgkmcnt(0)" ::: "memory");
}
__device__ __forceinline__ void sincos_d(double a, double& s, double& c) {
    const double k = __builtin_rint(a * 0.63661977236758134308);
    double r = __builtin_fma(-k, 1.57079632679489655800, a); r = __builtin_fma(-k, 6.123233995736766e-17, r);
    const double r2 = r * r;
    const double sp = r * (1.0 + r2 * (-1.0 / 6.0 + r2 * (1.0 / 120.0 + r2 * (-1.0 / 5040.0 + r2 * (1.0 / 362880.0 + r2 * (-1.0 / 39916800.0 + r2 * (1.0 / 6227020800.0)))))));
    const double cp = 1.0 + r2 * (-0.5 + r2 * (1.0 / 24.0 + r2 * (-1.0 / 720.0 + r2 * (1.0 / 40320.0 + r2 * (-1.0 / 3628800.0 + r2 * (1.0 / 479001600.0 + r2 * (-1.0 / 87178291200.0)))))));
    const int q = ((int)k) & 3;
    s = (q == 0) ? sp : (q == 1) ? cp : (q == 2) ? -sp : -cp;
    c = (q == 0) ? cp : (q == 1) ? -sp : (q == 2) ? -cp : sp;
}

struct Args { const float* in[23]; float* out; unsigned char* ws; int ph_lo, ph_hi, coop, pad; };
enum { I_X = 0, I_MEM, I_NMIXPRE, I_NMIXPOST, I_NFFNPRE, I_NFFNPOST, I_MEMNORM, I_WMEMKV, I_WINA, I_CONVW, I_CONVB, I_WGR, I_BGR, I_WGI, I_BGI, I_LAM, I_NKV, I_WKV, I_WINB, I_SINKS, I_WOUT, I_WFFI, I_WFFO };
constexpr int NPH = 17;

#define Wmkv ((bf16_t*)(args.ws + O_WMKV))
#define Wina ((bf16_t*)(args.ws + O_WINA))
#define Wg ((bf16_t*)(args.ws + O_WG))
#define Wkvq ((bf16_t*)(args.ws + O_WKVQ))
#define Wout ((bf16_t*)(args.ws + O_WOUT))
#define Wffi ((bf16_t*)(args.ws + O_WFFI))
#define Wffo ((bf16_t*)(args.ws + O_WFFO))
#define MEMN ((bf16_t*)(args.ws + O_MEMN))
#define MK ((bf16_t*)(args.ws + O_MK))
#define MVT ((bf16_t*)(args.ws + O_MVT))
#define HN ((bf16_t*)(args.ws + O_HN))
#define MIXED ((bf16_t*)(args.ws + O_MIXED))
#define KS ((bf16_t*)(args.ws + O_KS))
#define VST ((bf16_t*)(args.ws + O_VST))
#define XRLA ((bf16_t*)(args.ws + O_XRLA))
#define XC ((bf16_t*)(args.ws + O_XC))
#define GG ((bf16_t*)(args.ws + O_GG))
#define GATES ((bf16_t*)(args.ws + O_GATES))
#define MQ ((bf16_t*)(args.ws + O_MQ))
#define Y ((bf16_t*)(args.ws + O_Y))
#define Y1 ((bf16_t*)(args.ws + O_Y1))
#define HB ((bf16_t*)(args.ws + O_HB))
#define RS ((float*)(args.ws + O_RS))
#define Q ((bf16_t*)(args.ws + O_Q))
#define FF ((bf16_t*)(args.ws + O_FF))
#define rope ((float*)(args.ws + O_ROPE))
#define clam ((float*)(args.ws + O_CLAM))
#define H (args.out)
#define in (args.in)
#define XB_TMO      128
#define XB_XCNT(j)  (256  + 64 * (j))
#define XB_XSUB(j)  (1280 + 64 * (j))
#define XB_XGEN(j)  (2304 + 64 * (j))
#define XB_TOP      3328
#define XB_TOPGEN   3392
#define XCD_BAR_WORDS 3456
#define XB_SPIN_CAP (1u << 22)
__device__ __forceinline__ unsigned xb_ld(unsigned* p)              { return __hip_atomic_load(p, __ATOMIC_RELAXED, __HIP_MEMORY_SCOPE_AGENT); }
__device__ __forceinline__ unsigned xb_add(unsigned* p, unsigned v) { return __hip_atomic_fetch_add(p, v, __ATOMIC_RELAXED, __HIP_MEMORY_SCOPE_AGENT); }
__device__ __forceinline__ unsigned xb_xcc_id() { return (unsigned)__builtin_amdgcn_s_getreg((3 << 11) | 20) & 0xFu; }
#define XB_SPIN(cond, bar) do { unsigned _sp = 0; while (cond) { __builtin_amdgcn_s_sleep(1); \
    if ((++_sp & 255u) == 0u) { if (xb_ld(&(bar)[XB_TMO])) break; if (_sp > XB_SPIN_CAP) { atomicAdd(&(bar)[XB_TMO], 1u); break; } } } } while (0)
__device__ __forceinline__ void xcd_barrier_complete(unsigned* bar, unsigned x, unsigned& nloc, unsigned& nx) {
    const unsigned G = gridDim.x * gridDim.y * gridDim.z;
    unsigned sum, cnt, mine, sp = 0u;
    for (;;) {
        sum = 0u; cnt = 0u; mine = 0u;
#pragma unroll
        for (unsigned j = 0; j < 16; ++j) { const unsigned c = xb_ld(&bar[XB_XCNT(j)]); sum += c; cnt += (c > 0u) ? 1u : 0u; mine = (j == x) ? c : mine; }
        if (sum == G) break;
        __builtin_amdgcn_s_sleep(1);
        if ((++sp & 255u) == 0u) { if (xb_ld(&bar[XB_TMO])) break; if (sp > XB_SPIN_CAP) { atomicAdd(&bar[XB_TMO], 1u); break; } }
    }
    nloc = mine > 0u ? mine : 1u; nx = cnt > 0u ? cnt : 1u;
}
__device__ __forceinline__ void xcd_barrier(unsigned* bar, volatile LAS unsigned* st) {
    asm volatile("s_waitcnt vmcnt(0)" ::: "memory");
    __syncthreads();
    if (threadIdx.x == 0) {
        __builtin_amdgcn_s_waitcnt(0);
        const unsigned x = xb_xcc_id();
        unsigned nloc = st[0], nx = st[1];
        if (nloc == 0u) { xcd_barrier_complete(bar, x, nloc, nx); st[0] = nloc; st[1] = nx; }
        const unsigned old = xb_add(&bar[XB_XSUB(x)], 1u);
        const unsigned gen = old / nloc;
        if (old + 1u == (gen + 1u) * nloc) {
            __builtin_amdgcn_fence(__ATOMIC_RELEASE, "agent");
            asm volatile("s_waitcnt vmcnt(0)" ::: "memory");
            const unsigned og = xb_add(&bar[XB_TOP], 1u);
            const unsigned tg = og / nx;
            if (og + 1u == (tg + 1u) * nx) xb_add(&bar[XB_TOPGEN], 1u);
            else XB_SPIN(xb_ld(&bar[XB_TOPGEN]) == tg, bar);
            __builtin_amdgcn_fence(__ATOMIC_ACQUIRE, "agent");
            xb_add(&bar[XB_XGEN(x)], 1u);
            asm volatile("s_waitcnt vmcnt(0)" ::: "memory");
        } else {
            XB_SPIN(xb_ld(&bar[XB_XGEN(x)]) == gen, bar);
            __builtin_amdgcn_fence(__ATOMIC_ACQUIRE, "agent");
            asm volatile("s_waitcnt vmcnt(0)" ::: "memory");
        }
    }
    __syncthreads();
}
typedef const __attribute__((address_space(4))) Args* ArgsP;
__device__ __forceinline__ ArgsP get_args() { const unsigned long long a = (unsigned long long)__builtin_amdgcn_kernarg_segment_ptr(); unsigned lo32 = (unsigned)a, hi32 = (unsigned)(a >> 32);
    asm volatile("" : "+v"(lo32), "+v"(hi32)); lo32 = __builtin_amdgcn_readfirstlane(lo32); hi32 = __builtin_amdgcn_readfirstlane(hi32);
    return (ArgsP)(((unsigned long long)hi32 << 32) | lo32); }
#define args (*get_args())
__global__ void __launch_bounds__(512, 2) fwd_mega(Args args_by_value) {
    extern __shared__ __attribute__((aligned(16))) unsigned char lds_raw[];
    LAS unsigned char* lds = (LAS unsigned char*)lds_raw;
    const int G = gridDim.x, wg = blockIdx.x;
#define PHASE_IDS int tid = threadIdx.x; asm volatile("" : "+v"(tid)); const int lane = tid & 63, wave = __builtin_amdgcn_readfirstlane(tid >> 6); const int gw = wg * 8 + wave, ngw = G * 8; (void)lane; (void)gw; (void)ngw
    const int lo = args_by_value.ph_lo, hi = args_by_value.ph_hi, coop = args_by_value.coop;
#ifndef PHMASK
#define PHMASK 0x1FFFF
#endif
#ifndef DBL
#define DBL 0x0
#endif
#define NREP(k) ((((DBL) >> (k)) & 1) + 1)
#define IN(k) ((((PHMASK) >> (k)) & 1) && lo <= (k) && (k) < hi)
    if (coop == 2) cg::this_grid().sync();
    volatile LAS unsigned* xb_st = (volatile LAS unsigned*)(lds + LDS_BYTES - 64);
    if (coop) { if (threadIdx.x == 0) { xb_st[0] = 0u; xb_st[1] = 0u; (void)xb_add(&((unsigned*)args.ws)[XB_XCNT(xb_xcc_id())], 1u); } }
#define SYNC(k) do { if (coop && IN((k) + 1)) { xcd_barrier((unsigned*)args.ws, xb_st); } } while (0)

    if (IN(0)) for (int rep = 0; rep < NREP(0); ++rep) {
        PHASE_IDS;
        LAS float* scr = (LAS float*)(lds + wave * 16384);
        constexpr int I_MKV = 2 * 16 * 16, I_INA = 16 * 56, I_G = 12 * 2 * 4, I_KV = 16 * 16, I_INB = 16 * 32, I_OUT = 2 * 16 * 32, I_FFI = 2 * 16 * 176, I_FFO = 2 * 44 * 32;
        constexpr int NITEMS = I_MKV + I_INA + I_G + I_KV + I_INB + I_OUT + I_FFI + I_FFO;
        for (int it = gw; it < NITEMS; it += ngw) {
            int r = it;
            if (r < I_MKV) { const int l = r / 256, q = r % 256, kb = q / 16, nb = q % 16; tr_item(in[I_WMEMKV] + (size_t)l * 1024 * 512, 512, kb * 64, nb * 32, Wmkv, 1024, l * 512 + nb * 32, nullptr, scr, lane); continue; } r -= I_MKV;
            if (r < I_INA) { const int kb = r / 56, nb = r % 56; tr_item(in[I_WINA], A_IN, kb * 64, nb * 32, Wina, 1024, nb * 32, in[I_NMIXPRE], scr, lane); continue; } r -= I_INA;
            if (r < I_G) { const int mat = r / 8, q = r % 8, kb = q / 4, nb = q % 4; const int isI = mat / 6, h = mat % 6;
                tr_item((isI ? in[I_WGI] : in[I_WGR]) + (size_t)h * 128 * 128, 128, kb * 64, nb * 32, Wg + (size_t)h * 256 * 128, 128, isI * 128 + nb * 32, nullptr, scr, lane); continue; } r -= I_G;
            if (r < I_KV) { const int kb = r / 16, nb = r % 16; tr_item(in[I_WKV], 512, kb * 64, nb * 32, Wkvq, 1024, nb * 32, in[I_NKV], scr, lane); continue; } r -= I_KV;
            if (r < I_INB) { const int kb = r / 32, nb = r % 32; tr_item(in[I_WINB], 1024, kb * 64, nb * 32, Wkvq, 1024, 512 + nb * 32, in[I_NMIXPRE] + 1024, scr, lane); continue; } r -= I_INB;
            if (r < I_OUT) { const int l = r / 512, q = r % 512, kb = q / 32, nb = q % 32; tr_item(in[I_WOUT] + (size_t)l * 1024 * 1024, 1024, kb * 64, nb * 32, Wout + (size_t)l * 1024 * 1024, 1024, nb * 32, nullptr, scr, lane); continue; } r -= I_OUT;
            if (r < I_FFI) { const int l = r / 2816, q = r % 2816, kb = q / 176, nb = q % 176; const int c0 = nb * 32; const int isU = c0 >= DFF, f = c0 - isU * DFF;
                tr_item(in[I_WFFI] + (size_t)l * 1024 * 5632, 5632, kb * 64, c0, Wffi + (size_t)l * 5632 * 1024, 1024, (f / 128) * 256 + isU * 128 + (f % 128), in[I_NFFNPRE] + l * 1024, scr, lane); continue; } r -= I_FFI;
            { const int l = r / 1408, q = r % 1408, kb = q / 32, nb = q % 32; tr_item(in[I_WFFO] + (size_t)l * DFF * 1024, 1024, kb * 64, nb * 32, Wffo + (size_t)l * 1024 * DFF, DFF, nb * 32, nullptr, scr, lane); }
        }
        for (int e = wg * 512 + tid; e < SEQ * 8; e += G * 512) { const int s = e >> 3, i = e & 7;
            const double inv_freq[8] = {1.0, 0.19392274474868576, 0.03760603093086393, 0.007292664737217109, 0.001414213562373095, 0.0002742481756762073, 5.318295896944988e-05, 1.031338537721246e-05};
            double f = inv_freq[0];
#pragma unroll
            for (int q = 1; q < 8; ++q) f = (i == q) ? inv_freq[q] : f;
            double sn, cs; sincos_d((double)s * f, sn, cs); rope[s * 16 + i] = (float)cs; rope[s * 16 + 8 + i] = (float)sn; }
        for (int e = wg * 512 + tid; e < LRU_W; e += G * 512) { const float lam = in[I_LAM][e]; const float ls = fminf(lam, 0.f) - log1pf(expf(-fabsf(lam))); clam[e] = 8.f * ls * LOG2E; }
        norm_rows<false, false>(in[I_MEM], nullptr, nullptr, nullptr, in[I_MEMNORM], MEMN, nullptr, TM, gw, ngw, lane);
        norm_rows<false, true>(in[I_X], nullptr, nullptr, HB, nullptr, nullptr, RS, T, gw, ngw, lane);
    }
    SYNC(0);
    if (IN(1)) for (int rep = 0; rep < NREP(1); ++rep) {
        { pg8::Gemm g{MEMN, Wmkv, TM, 1024, 1024, 1024, 1024, 0}; pg8::StaticOrder S; S.init(TM, 1024, G, (wg + G / 2) % G); pg8::EpiMkv E{MK, MVT}; pg8::gemm_phase(lds, g, S, E); }
        { pg8::Gemm g{HB, Wina, T, A_IN, 1024, 1024, 1024, 0}; pg8::StaticOrder S; S.init(T, A_IN, G, wg); pg8::EpiProjA E{XRLA, GG, MQ, RS}; pg8::gemm_phase(lds, g, S, E); }
    }
    SYNC(1);
    if (IN(2)) for (int rep = 0; rep < NREP(2); ++rep) {
        PHASE_IDS;
        const float* cw = in[I_CONVW]; const float* cb = in[I_CONVB];
        for (int it = wg * 512 + tid; it < (T / 16) * 96; it += G * 512) {
            const int ch = (it % 96) * 8, rb = (it / 96) * 16;
            float w[4][8], bb[8];
#pragma unroll
            for (int k = 0; k < 4; ++k) { const f32x4 a = *(const f32x4*)(cw + k * LRU_W + ch), b2 = *(const f32x4*)(cw + k * LRU_W + ch + 4);
#pragma unroll
                for (int j = 0; j < 4; ++j) { w[k][j] = a[j]; w[k][4 + j] = b2[j]; } }
            { const f32x4 a = *(const f32x4*)(cb + ch), b2 = *(const f32x4*)(cb + ch + 4);
#pragma unroll
              for (int j = 0; j < 4; ++j) { bb[j] = a[j]; bb[4 + j] = b2[j]; } }
            float xw[4][8];
            const bool head = (rb & (SEQ - 1)) == 0;
#pragma unroll
            for (int q = 0; q < 3; ++q) { u32x4 v = (u32x4){0u, 0u, 0u, 0u}; if (!head) v = *(const u32x4*)(XRLA + (size_t)(rb - 3 + q) * LRU_W + ch);
#pragma unroll
                for (int j = 0; j < 4; ++j) { xw[q][2 * j] = bf_lo(v[j]); xw[q][2 * j + 1] = bf_hi(v[j]); } }
            u32x4 rowv[16];
#pragma unroll
            for (int rr = 0; rr < 16; ++rr) rowv[rr] = *(const u32x4*)(XRLA + (size_t)(rb + rr) * LRU_W + ch);
#pragma unroll
            for (int rr = 0; rr < 16; ++rr) {
                const u32x4 v = rowv[rr]; float o[8];
#pragma unroll
                for (int j = 0; j < 4; ++j) { xw[3][2 * j] = bf_lo(v[j]); xw[3][2 * j + 1] = bf_hi(v[j]); }
#pragma unroll
                for (int j = 0; j < 8; ++j) o[j] = bb[j] + w[0][j] * xw[0][j] + w[1][j] * xw[1][j] + w[2][j] * xw[2][j] + w[3][j] * xw[3][j];
                u32x4 ow; ow.x = cvt_pk_bf16(o[0], o[1]); ow.y = cvt_pk_bf16(o[2], o[3]); ow.z = cvt_pk_bf16(o[4], o[5]); ow.w = cvt_pk_bf16(o[6], o[7]);
                *(u32x4*)(XC + (size_t)(rb + rr) * LRU_W + ch) = ow;
#pragma unroll
                for (int j = 0; j < 8; ++j) { xw[0][j] = xw[1][j]; xw[1][j] = xw[2][j]; xw[2][j] = xw[3][j]; }
            }
        }
        if (G <= BATCH * 24) mem_attn_phase((LAS char*)lds, MQ, 256, 0, MK, MVT, Y, wg, G);
    }
    SYNC(2);
    if (IN(4)) for (int rep = 0; rep < NREP(4); ++rep) {
        PHASE_IDS;
        LAS char* Bl = (LAS char*)lds;
        LAS f32x2* sl = (LAS f32x2*)(lds + 64 * 272);
        const int n32 = lane & 31, hi = lane >> 5;
        const int tau = 16 * ((n32 >> 2) & 1) + (n32 & 3) + 4 * (n32 >> 3);
        if (G > BATCH * 24 && wg >= BATCH * 24) mem_attn_phase((LAS char*)lds, MQ, 256, 0, MK, MVT, Y, wg - BATCH * 24, G - BATCH * 24);
        for (int wgi = wg; wgi < BATCH * 24; wgi += G) {
            const int grp = (wgi & 7) + 8 * (wgi >> 5), q = (wgi >> 3) & 3;
            const int b = grp / 6, hb = grp % 6, c0 = q * 32, ch = hb * 128 + c0 + n32;
            __syncthreads();
            for (int c = tid; c < 64 * 16; c += 512) { const int row = c >> 4, kc = c & 15; const int wrow = (row < 32) ? (c0 + row) : (128 + c0 + row - 32);
                *(LAS u32x4*)(Bl + row * 272 + kc * 16) = *(const u32x4*)(Wg + ((size_t)hb * 256 + wrow) * 128 + kc * 8); }
            const float brv = in[I_BGR][ch], biv = in[I_BGI][ch], clv = clam[ch];
            __syncthreads();
            float hc = 0.f;
            LAS char* At = (LAS char*)lds + 64 * 272 + 16384 + wave * (32 * 272);
            const int lrow = lane >> 4, lcol = lane & 15;
            const bf16_t* xg_u = XC + ((size_t)b * SEQ + wave * 64 + lrow) * LRU_W + hb * 128 + lcol * 8;
            const bf16_t* gp_u = GG + ((size_t)b * SEQ + wave * 64 + 16 * hi) * LRU_W + ch;
            bf16_t* yp_u = Y + ((size_t)b * SEQ + wave * 64 + 16 * hi) * 1024 + ch;
            u32x4 st[2][8];
#pragma unroll
            for (int k = 0; k < 2; ++k)
#pragma unroll
                for (int i = 0; i < 8; ++i) st[k][i] = *(const u32x4*)(xg_u + (size_t)(k * 32 + i * 4) * LRU_W);
            for (int chunk = 0; chunk < 8; ++chunk) {
                float av[2][16], uv[2][16]; unsigned short gr[2][16];
                LAS f32x2* buf = sl + (chunk & 1) * 1024;
                const int cn = (chunk + 1 < 8) ? chunk + 1 : chunk;
#pragma unroll
                for (int k = 0; k < 2; ++k) {
#pragma unroll
                    for (int i = 0; i < 8; ++i) *(LAS u32x4*)(At + (i * 4 + lrow) * 272 + lcol * 16) = st[k][i];
#pragma unroll
                    for (int i = 0; i < 8; ++i) st[k][i] = *(const u32x4*)(xg_u + (size_t)(cn * 512 + k * 32 + i * 4) * LRU_W);
                    asm volatile("s_waitcnt lgkmcnt(0)" ::: "memory");
                    f32x16 accr, acci; const f32x16 z16 = {0.f, 0.f, 0.f, 0.f, 0.f, 0.f, 0.f, 0.f, 0.f, 0.f, 0.f, 0.f, 0.f, 0.f, 0.f, 0.f};
#pragma unroll
                    for (int ks = 0; ks < 8; ++ks) {
                        const bf16x8 afr = *(const LAS bf16x8*)(At + tau * 272 + ks * 32 + hi * 16);
                        const bf16x8 bfr = *(const LAS bf16x8*)(Bl + n32 * 272 + ks * 32 + hi * 16), bfi = *(const LAS bf16x8*)(Bl + (32 + n32) * 272 + ks * 32 + hi * 16);
                        accr = __builtin_amdgcn_mfma_f32_32x32x16_bf16(afr, bfr, ks ? accr : z16, 0, 0, 0);
                        acci = __builtin_amdgcn_mfma_f32_32x32x16_bf16(afr, bfi, ks ? acci : z16, 0, 0, 0);
                    }
                    float P = 1.f, L = 0.f;
#pragma unroll
                    for (int r = 0; r < 16; ++r) {
                        const unsigned short xs = *(const LAS unsigned short*)(At + (16 * hi + r) * 272 + (c0 + n32) * 2);
                        const float rr = sigmoidf_(accr[r] + brv), ii = sigmoidf_(acci[r] + biv);
                        const float a = ex2(rr * clv); float mlt = __builtin_amdgcn_sqrtf(1.f - a * a);
                        if (r == 0 && hi == 0 && k == 0 && chunk == 0 && wave == 0) mlt = 1.f;
                        const float u = mlt * ii * bf_lo((unsigned)xs);
                        av[k][r] = a; uv[k][r] = u;
                        L = a * L + u; P *= a;
                    }
                    buf[(wave * 4 + k * 2 + hi) * 32 + n32] = (f32x2){P, L};
                    asm volatile("s_waitcnt lgkmcnt(0)" ::: "memory");
                }
#pragma unroll
                for (int k = 0; k < 2; ++k)
#pragma unroll
                    for (int r = 0; r < 16; ++r) gr[k][r] = gp_u[(size_t)(chunk * 512 + k * 32 + r) * LRU_W];
                __syncthreads();
                float h = hc, hin0 = 0.f, hin1 = 0.f; const int sg0 = wave * 4 + hi, sg1 = sg0 + 2;
#pragma unroll 8
                for (int s2 = 0; s2 < 32; ++s2) { if (s2 == sg0) hin0 = h; if (s2 == sg1) hin1 = h; const f32x2 e0 = buf[s2 * 32 + n32]; h = e0.x * h + e0.y; }
                hc = h;
#pragma unroll
                for (int k = 0; k < 2; ++k) {
                    float hh = k ? hin1 : hin0;
                    bf16_t* yp = yp_u + (size_t)(chunk * 512 + k * 32) * 1024;
#pragma unroll
                    for (int r = 0; r < 16; ++r) { hh = av[k][r] * hh + uv[k][r]; yp[(size_t)r * 1024] = (bf16_t)(cvt_pk_bf16(hh * bf_lo((unsigned)gr[k][r]), 0.f) & 0xffffu); }
                }
            }
        }
    }
    SYNC(4);
    if (IN(5)) for (int rep = 0; rep < NREP(5); ++rep) { pg8::Gemm g{Y, Wout, T, 1024, 1024, 1024, 1024, 0}; pg8::StaticOrder S; S.init(T, 1024, G, wg); pg8::EpiPlain E{MIXED, 1024}; pg8::gemm_phase(lds, g, S, E); }
    SYNC(5);
    if (IN(6)) for (int rep = 0; rep < NREP(6); ++rep) { PHASE_IDS; norm_rows<true, true>(HB, MIXED, in[I_NMIXPOST], HB, nullptr, nullptr, RS, T, gw, ngw, lane); }
    SYNC(6);
    if (IN(7)) for (int rep = 0; rep < NREP(7); ++rep) { pg8::Gemm g{HB, Wffi, T, 5632, 1024, 1024, 1024, 0}; pg8::StaticOrder S; S.init(T, 5632, G, wg); pg8::EpiSwiglu E{FF, RS}; pg8::gemm_phase(lds, g, S, E); }
    SYNC(7);
    if (IN(8)) for (int rep = 0; rep < NREP(8); ++rep) { pg8::Gemm g{FF, Wffo, T, 1024, DFF, DFF, DFF, 0}; pg8::StaticOrder S; S.init(T, 1024, G, wg); pg8::EpiPlain E{MIXED, 1024}; pg8::gemm_phase(lds, g, S, E); }
    SYNC(8);
    if (IN(9)) for (int rep = 0; rep < NREP(9); ++rep) { PHASE_IDS; norm_rows<true, true>(HB, MIXED, in[I_NFFNPOST], HB, nullptr, nullptr, RS, T, gw, ngw, lane); }
    SYNC(9);
    if (IN(10)) for (int rep = 0; rep < NREP(10); ++rep) { pg8::Gemm g{HB, Wkvq, T, 1536, 1024, 1024, 1024, 0}; pg8::StaticOrder S; S.init(T, 1536, G, wg); pg8::EpiKvq E{KS, VST, Q, rope, RS}; pg8::gemm_phase(lds, g, S, E); }
    SYNC(10);
    if (IN(11)) for (int rep = 0; rep < NREP(11); ++rep) {
        swa_phase((LAS char*)lds, Q, KS, VST, in[I_SINKS], Y1, wg, G);
        mem_attn_phase((LAS char*)lds, Q, 1024, LRU_W, MK + (size_t)TM * 256, MVT + (size_t)TM * 256, Y1, wg, G);
    }
    SYNC(11);
    if (IN(12)) for (int rep = 0; rep < NREP(12); ++rep) { pg8::Gemm g{Y1, Wout + (size_t)1024 * 1024, T, 1024, 1024, 1024, 1024, 0}; pg8::StaticOrder S; S.init(T, 1024, G, wg); pg8::EpiPlain E{MIXED, 1024}; pg8::gemm_phase(lds, g, S, E); }
    SYNC(12);
    if (IN(13)) for (int rep = 0; rep < NREP(13); ++rep) { PHASE_IDS; norm_rows<true, true>(HB, MIXED, in[I_NMIXPOST] + 1024, HB, nullptr, nullptr, RS, T, gw, ngw, lane); }
    SYNC(13);
    if (IN(14)) for (int rep = 0; rep < NREP(14); ++rep) { pg8::Gemm g{HB, Wffi + (size_t)5632 * 1024, T, 5632, 1024, 1024, 1024, 0}; pg8::StaticOrder S; S.init(T, 5632, G, wg); pg8::EpiSwiglu E{FF, RS}; pg8::gemm_phase(lds, g, S, E); }
    SYNC(14);
    if (IN(15)) for (int rep = 0; rep < NREP(15); ++rep) { pg8::Gemm g{FF, Wffo + (size_t)1024 * DFF, T, 1024, DFF, DFF, DFF, 0}; pg8::StaticOrder S; S.init(T, 1024, G, wg); pg8::EpiPlain E{MIXED, 1024}; pg8::gemm_phase(lds, g, S, E); }
    SYNC(15);
    if (IN(16)) for (int rep = 0; rep < NREP(16); ++rep) { PHASE_IDS; norm_rows<true, false>(HB, MIXED, in[I_NFFNPOST] + 1024, H, nullptr, nullptr, nullptr, T, gw, ngw, lane); }
#undef IN
#undef SYNC
}

#undef args
#undef Wmkv
#undef Wina
#undef Wg
#undef Wkvq
#undef Wout
#undef Wffi
#undef Wffo
#undef MEMN
#undef MK
#undef MVT
#undef HN
#undef MIXED
#undef KS
#undef VST
#undef XRLA
#undef XC
#undef GG
#undef GATES
#undef MQ
#undef Y
#undef Y1
#undef HB
#undef RS
#undef Q
#undef FF
#undef rope
#undef clam
#undef H
#undef in
extern "C" void kernel_launch(void* const* d_in, const int* in_sizes, int n_in, void* d_out, int out_size, void* d_ws, size_t ws_size, hipStream_t stream) {
    static int grid = 0;
    if (grid == 0) {
        if (n_in != 23 || in_sizes[0] != T * D || out_size != T * D || ws_size < WS_NEED) { fprintf(stderr, "kernel_launch: unexpected shapes (n_in %d, in0 %d, out %d, ws %zu < %zu)\n", n_in, n_in > 0 ? in_sizes[0] : -1, out_size, ws_size, (size_t)WS_NEED); grid = -1; return; }
        int dev = 0, cus = 0, per_cu = 0;
        (void)hipGetDevice(&dev); (void)hipDeviceGetAttribute(&cus, hipDeviceAttributeMultiprocessorCount, dev);
        if (hipFuncSetAttribute((const void*)fwd_mega, hipFuncAttributeMaxDynamicSharedMemorySize, LDS_BYTES) != hipSuccess) { fprintf(stderr, "kernel_launch: hipFuncSetAttribute failed\n"); grid = -1; return; }
        if (hipOccupancyMaxActiveBlocksPerMultiprocessor(&per_cu, (const void*)fwd_mega, 512, LDS_BYTES) != hipSuccess || per_cu < 1) { fprintf(stderr, "kernel_launch: occupancy query says %d\n", per_cu); per_cu = 1; }
        (void)hipGetLastError();
        grid = cus * per_cu;
        fprintf(stderr, "kernel_launch: grid %d (cus %d x %d)\n", grid, cus, per_cu);
    }
    if (grid < 0) return;
    if (hipMemsetAsync(d_ws, 0, 65536, stream) != hipSuccess) { fprintf(stderr, "kernel_launch: memset failed\n"); return; }
    Args a{};
    for (int i = 0; i < 23; ++i) a.in[i] = (const float*)d_in[i];
    a.out = (float*)d_out; a.ws = (unsigned char*)d_ws; a.pad = 0;
#if MK_MULTI
    for (int ph = 0; ph < NPH; ++ph) { a.ph_lo = ph; a.ph_hi = ph + 1; a.coop = 0; hipLaunchKernelGGL(fwd_mega, dim3(grid), dim3(512), LDS_BYTES, stream, a); }
#else
    a.ph_lo = 0; a.ph_hi = NPH; a.coop = 1;
    void* kargs[] = {&a};
    hipError_t e = hipLaunchCooperativeKernel((const void*)fwd_mega, dim3(grid), dim3(512), kargs, LDS_BYTES, stream);
    if (e != hipSuccess) fprintf(stderr, "kernel_launch: cooperative launch failed: %s (grid %d)\n", hipGetErrorString(e), grid);
#endif
}
```

```cpp
#include <hip/hip_runtime.h>
#include <hip/hip_cooperative_groups.h>
#include <cstdio>
#include <cstdint>
namespace cg = cooperative_groups;

#define LAS __attribute__((address_space(3)))
typedef unsigned short bf16_t;
typedef short bf16x8 __attribute__((ext_vector_type(8)));
typedef short s16x4 __attribute__((ext_vector_type(4)));
typedef float f32x4 __attribute__((ext_vector_type(4)));
typedef float f32x2 __attribute__((ext_vector_type(2)));
typedef float f32x16 __attribute__((ext_vector_type(16)));
typedef unsigned u32x4 __attribute__((ext_vector_type(4)));
typedef unsigned u32x2 __attribute__((ext_vector_type(2)));

#ifndef MK_MULTI
#define MK_MULTI 0
#endif

constexpr int D = 1024, BATCH = 8, SEQ = 4096, T = BATCH * SEQ, NMEM = 256, TM = BATCH * NMEM;
constexpr int LRU_W = 768, MEM_W = 256, DFF = 2816, A_IN = 1792;
constexpr float EPS = 1e-6f;
constexpr float LOG2E = 1.4426950408889634f;
constexpr float QSCALE = 0.125f * LOG2E;

constexpr size_t MiB = 1u << 20;
constexpr size_t al256(size_t x) { return (x + 255) & ~(size_t)255; }
constexpr size_t O_WMKV = 1 * MiB;
constexpr size_t O_WINA = O_WMKV + (size_t)1024 * 1024 * 2;
constexpr size_t O_WG   = O_WINA + (size_t)A_IN * 1024 * 2;
constexpr size_t O_WKVQ = O_WG + (size_t)6 * 256 * 128 * 2;
constexpr size_t O_WOUT = O_WKVQ + (size_t)1536 * 1024 * 2;
constexpr size_t O_WFFI = O_WOUT + (size_t)2 * 1024 * 1024 * 2;
constexpr size_t O_WFFO = O_WFFI + (size_t)2 * 5632 * 1024 * 2;
constexpr size_t O_ROPE = O_WFFO + (size_t)2 * 1024 * DFF * 2;
constexpr size_t O_CLAM = O_ROPE + (size_t)4096 * 16 * 4;
constexpr size_t O_MEMN = al256(O_CLAM + 768 * 4);
constexpr size_t O_MK   = O_MEMN + (size_t)TM * 1024 * 2;
constexpr size_t O_MVT  = O_MK + (size_t)2 * TM * 256 * 2;
constexpr size_t O_RS   = O_MVT + (size_t)2 * TM * 256 * 2;
constexpr size_t O_END_SMALL = O_RS + (size_t)T * 4;
static_assert(O_END_SMALL <= 64 * MiB, "small region");
constexpr size_t O_HN    = 64 * MiB;
constexpr size_t O_MIXED = 128 * MiB;
constexpr size_t O_KS    = 192 * MiB;
constexpr size_t O_VST   = 208 * MiB;
constexpr size_t O_MIX   = 224 * MiB;
constexpr size_t O_XRLA  = O_MIX;
constexpr size_t O_GATES = O_MIX;
constexpr size_t O_XC    = O_MIX + 96 * MiB;
constexpr size_t O_GG    = O_MIX + 144 * MiB;
constexpr size_t O_MQ    = O_MIX + 192 * MiB;
constexpr size_t O_Y     = O_MIX + 208 * MiB;
constexpr size_t O_Q     = O_MIX;
constexpr size_t O_Y1    = O_MIX + 64 * MiB;
constexpr size_t O_HB    = O_HN;
constexpr size_t O_FF    = O_MIX;
constexpr size_t WS_NEED = O_MIX + 272 * MiB;

constexpr int LDS_BYTES = 147456;

__device__ __forceinline__ unsigned cvt_pk_bf16(float lo, float hi) { unsigned r; asm volatile("v_cvt_pk_bf16_f32 %0, %1, %2" : "=v"(r) : "v"(lo), "v"(hi)); return r; }
__device__ __forceinline__ float bf_lo(unsigned w) { return __uint_as_float(w << 16); }
__device__ __forceinline__ float bf_hi(unsigned w) { return __uint_as_float(w & 0xffff0000u); }
__device__ __forceinline__ float ex2(float x) { return __builtin_amdgcn_exp2f(x); }
__device__ __forceinline__ float rcpf_(float x) { return __builtin_amdgcn_rcpf(x); }
__device__ __forceinline__ float sigmoidf_(float x) { return rcpf_(1.f + ex2(-x * LOG2E)); }
__device__ __forceinline__ float gelu_tanh(float x) { const float u = 0.7978845608028654f * (x + 0.044715f * x * x * x); return x * rcpf_(1.f + ex2(-2.f * LOG2E * u)); }
__device__ __forceinline__ float wave_sum(float v) {
#pragma unroll
    for (int o = 1; o < 64; o <<= 1) v += __shfl_xor(v, o);
    return v;
}

namespace pg8 {
constexpr int BM = 256, BK = 64, HALF = 128, HTB = HALF * BK * 2, STAGE_BYTES = 8 * HTB, NXCD = 8, WGM = 8;
__host__ __device__ __forceinline__ int lds_byte(int r, int c) { const int st = (r >> 4) * 2 + (c >> 5), rr = r & 15, cc = c & 31, ob = rr * 64 + cc * 2; return st * 1024 + (ob ^ (((ob >> 9) & 1) << 5)); }
__host__ __device__ __forceinline__ void stage_rc(int b, int& R, int& C) { const int st = b / 1024, sb = b % 1024, swz = sb ^ (((sb >> 9) & 1) << 5); R = (st >> 1) * 16 + swz / 64; C = (st & 1) * 32 + (swz % 64) / 2; }
__host__ __device__ __forceinline__ int perm32(int rho) { const int n = rho >> 4, i = rho & 15; return 8 * (i >> 2) + 4 * n + (i & 3); }

struct Unit { int pm, pn; };
struct Gemm { const bf16_t* A; const bf16_t* Bt; int M, N, K, lda, ldb, a_pn_off; };

struct StaticOrder {
    int nM, nN, nwg, G, c;
    __host__ __device__ void init(int M, int N, int G_, int c_) { nM = M / BM; nN = N / BM; nwg = nM * nN; G = G_; c = c_; }
    __host__ __device__ bool next(int i, Unit& u) const {
        const long L = (long)i * G + c; if (L >= nwg) return false;
        int wgid = (int)L; { const int q = nwg / NXCD, r = nwg % NXCD, xcd = wgid % NXCD, off = wgid / NXCD; wgid = (xcd < r ? xcd * (q + 1) : r * (q + 1) + (xcd - r) * q) + off; }
        const int nig = WGM * nN, gid = wgid / nig, fm = gid * WGM, gsz = (nM - fm) < WGM ? (nM - fm) : WGM;
        u.pm = fm + ((wgid % nig) % gsz); u.pn = (wgid % nig) / gsz; return true;
    }
};

template <class Epi>
__device__ __forceinline__ void gemm_phase(LAS unsigned char* lds, const Gemm g, const StaticOrder& S, const Epi& E) {
    const int tid = threadIdx.x, wid = __builtin_amdgcn_readfirstlane(tid >> 6), lane = tid & 63, wr = wid >> 2, wc = wid & 3, fr = lane & 15, fq = lane >> 4;
    const int K = g.K, nt = K / BK;
    unsigned voffA, voffB;
    { int R, C; stage_rc(tid * 16, R, C); const int Rb = (R & ~31) + perm32(R & 31); voffA = (unsigned)(R * g.lda + C) * 2u; voffB = (unsigned)(Rb * g.ldb + C) * 2u; }
    const unsigned rstepA = 64u * (unsigned)g.lda * 2u, rstepB = 64u * (unsigned)g.ldb * 2u;
    const size_t kstep = (size_t)(BK * 2);
    const size_t hstepA = (size_t)HALF * g.lda * 2, hstepB = (size_t)HALF * g.ldb * 2;
    const size_t tstepA = 2 * hstepA, tstepB = 2 * hstepB;
    const unsigned ldsw = (unsigned)wid * 1024u;
    const int aoff = lds_byte(wr * 64 + fr, fq * 8), boff = lds_byte(wc * 32 + fr, fq * 8);
#define PG8_SA(b, h) (((b) * 2 + (h)) * HTB)
#define PG8_SB(b, h) ((4 + (b) * 2 + (h)) * HTB)
#define PG8_STAGE(bufoff, gbase, voff) do { _Pragma("unroll") for (int _i = 0; _i < 2; ++_i) \
        __builtin_amdgcn_global_load_lds((const unsigned*)((const char*)(gbase) + (size_t)_i * PG8_RSTEP_##voff + voff), (LAS unsigned*)(lds + (bufoff) + ldsw + _i * 8192), 16, 0, 0); } while (0)
#define PG8_RSTEP_voffA rstepA
#define PG8_RSTEP_voffB rstepB
#define PG8_LDA(dst, b, h) do { _Pragma("unroll") for (int m = 0; m < 4; ++m) _Pragma("unroll") for (int k = 0; k < 2; ++k) dst[m][k] = *(const LAS bf16x8*)(lds + PG8_SA(b, h) + aoff + m * 2048 + k * 1024); } while (0)
#define PG8_LDB(dst, b, h) do { _Pragma("unroll") for (int n = 0; n < 2; ++n) _Pragma("unroll") for (int k = 0; k < 2; ++k) dst[n][k] = *(const LAS bf16x8*)(lds + PG8_SB(b, h) + boff + n * 2048 + k * 1024); } while (0)
#define PG8_MMA(ai, bj, At, Bt) do { __builtin_amdgcn_s_setprio(1); _Pragma("unroll") for (int m = 0; m < 4; ++m) _Pragma("unroll") for (int n = 0; n < 2; ++n) _Pragma("unroll") for (int k = 0; k < 2; ++k) \
        acc[ai][bj][m][n] = __builtin_amdgcn_mfma_f32_16x16x32_bf16(Bt[n][k], At[m][k], acc[ai][bj][m][n], 0, 0, 0); __builtin_amdgcn_s_setprio(0); } while (0)
#define PG8_MMA0(ai, bj, At, Bt) do { __builtin_amdgcn_s_setprio(1); _Pragma("unroll") for (int m = 0; m < 4; ++m) _Pragma("unroll") for (int n = 0; n < 2; ++n) { \
        acc[ai][bj][m][n] = __builtin_amdgcn_mfma_f32_16x16x32_bf16(Bt[n][0], At[m][0], (f32x4){0.f, 0.f, 0.f, 0.f}, 0, 0, 0); \
        acc[ai][bj][m][n] = __builtin_amdgcn_mfma_f32_16x16x32_bf16(Bt[n][1], At[m][1], acc[ai][bj][m][n], 0, 0, 0); } __builtin_amdgcn_s_setprio(0); } while (0)
#define PG8_WAIT_V(n) asm volatile("s_waitcnt vmcnt(" #n ")" ::: "memory")
#define PG8_WAIT_L(n) asm volatile("s_waitcnt lgkmcnt(" #n ")" ::: "memory")
#define PG8_BAR __builtin_amdgcn_s_barrier()
#define PG8_SCHED __builtin_amdgcn_sched_barrier(0)
    Unit cur, nxt; int ui = 0;
    if (!S.next(0, cur)) return;
    f32x4 acc[2][2][4][2];
    bf16x8 At[4][2], B0[2][2], B1[2][2];
    const char* cA = (const char*)g.A + (size_t)cur.pm * tstepA + (size_t)cur.pn * g.a_pn_off * 2; const char* cB = (const char*)g.Bt + (size_t)cur.pn * tstepB;
    PG8_STAGE(PG8_SB(0, 0), cB, voffB); PG8_STAGE(PG8_SB(0, 1), cB + hstepB, voffB); PG8_STAGE(PG8_SA(0, 0), cA, voffA); PG8_STAGE(PG8_SA(0, 1), cA + hstepA, voffA);
    if (wr == 1) PG8_BAR;
    PG8_WAIT_V(2); PG8_BAR;
    PG8_STAGE(PG8_SB(1, 0), cB + kstep, voffB); PG8_STAGE(PG8_SA(1, 0), cA + kstep, voffA); PG8_STAGE(PG8_SB(1, 1), cB + hstepB + kstep, voffB);
    PG8_WAIT_V(6); PG8_BAR;
    for (;;) {
        const bool has_next = S.next(ui + 1, nxt);
        const char* nA = has_next ? (const char*)g.A + (size_t)nxt.pm * tstepA + (size_t)nxt.pn * g.a_pn_off * 2 : cA; const char* nB = has_next ? (const char*)g.Bt + (size_t)nxt.pn * tstepB : cB;
        float pre[8]; E.prefetch(pre, cur, wr, fr);
        for (int t = 0; t < nt; t += 2) {
            const bool last = (t == nt - 2);
            const char* a1 = cA + (size_t)(t + 1) * kstep;
            const char* a2 = last ? nA : cA + (size_t)(t + 2) * kstep; const char* b2 = last ? nB : cB + (size_t)(t + 2) * kstep;
            const char* a3 = a2 + kstep; const char* b3 = b2 + kstep;
            PG8_LDB(B0, 0, 0); PG8_LDB(B1, 0, 1); PG8_SCHED; PG8_LDA(At, 0, 0); PG8_STAGE(PG8_SA(1, 1), a1 + hstepA, voffA);
            PG8_WAIT_V(8); PG8_WAIT_L(0); PG8_BAR; if (t == 0) { PG8_MMA0(0, 0, At, B0); PG8_MMA0(0, 1, At, B1); } else { PG8_MMA(0, 0, At, B0); PG8_MMA(0, 1, At, B1); } PG8_BAR; PG8_SCHED;
            PG8_LDA(At, 0, 1); PG8_STAGE(PG8_SB(0, 0), b2, voffB); PG8_STAGE(PG8_SB(0, 1), b2 + hstepB, voffB); PG8_STAGE(PG8_SA(0, 0), a2, voffA);
            PG8_WAIT_V(8); PG8_WAIT_L(0); PG8_BAR; if (t == 0) { PG8_MMA0(1, 0, At, B0); PG8_MMA0(1, 1, At, B1); } else { PG8_MMA(1, 0, At, B0); PG8_MMA(1, 1, At, B1); } PG8_BAR; PG8_SCHED;
            PG8_LDB(B0, 1, 0); PG8_LDB(B1, 1, 1); PG8_SCHED; PG8_LDA(At, 1, 0); PG8_STAGE(PG8_SA(0, 1), a2 + hstepA, voffA);
            PG8_WAIT_V(8); PG8_WAIT_L(0); PG8_BAR; PG8_MMA(0, 0, At, B0); PG8_MMA(0, 1, At, B1); PG8_BAR; PG8_SCHED;
            PG8_LDA(At, 1, 1); PG8_STAGE(PG8_SB(1, 0), b3, voffB); PG8_STAGE(PG8_SB(1, 1), b3 + hstepB, voffB); PG8_STAGE(PG8_SA(1, 0), a3, voffA);
            PG8_WAIT_V(8); PG8_WAIT_L(0); PG8_BAR; PG8_MMA(1, 0, At, B0); PG8_MMA(1, 1, At, B1); PG8_BAR; PG8_SCHED;
        }
        if (wr == 0) PG8_BAR;
        E(acc, cur, wr, wc, fr, fq, pre);
        if (!has_next) break;
        cur = nxt; cA = nA; cB = nB; ++ui;
        if (wr == 1) PG8_BAR;
    }
    PG8_WAIT_V(0);
    PG8_BAR;
#undef PG8_SA
#undef PG8_SB
#undef PG8_STAGE
#undef PG8_RSTEP_voffA
#undef PG8_RSTEP_voffB
#undef PG8_LDA
#undef PG8_LDB
#undef PG8_MMA
#undef PG8_MMA0
#undef PG8_WAIT_V
#undef PG8_WAIT_L
#undef PG8_BAR
#undef PG8_SCHED
}

typedef f32x4 Acc[2][2][4][2];
__device__ __forceinline__ void store8(bf16_t* p, f32x4 v0, f32x4 v1) {
    u32x4 w; w.x = cvt_pk_bf16(v0[0], v0[1]); w.y = cvt_pk_bf16(v0[2], v0[3]); w.z = cvt_pk_bf16(v1[0], v1[1]); w.w = cvt_pk_bf16(v1[2], v1[3]);
    *(u32x4*)p = w;
}

struct EpiPlain {
    bf16_t* O; int ldc;
    __device__ __forceinline__ void prefetch(float (&pre)[8], const Unit&, int, int) const {}
    __device__ __forceinline__ void operator()(const Acc& acc, const Unit& u, int wr, int wc, int fr_in, int fq_in, const float (&pre)[8]) const {
        int fr = fr_in, fq = fq_in; asm volatile("" : "+v"(fr), "+v"(fq));
        const int row0 = u.pm * BM + wr * 64 + fr, col0 = u.pn * BM + wc * 32 + 8 * fq;
#pragma unroll
        for (int ai = 0; ai < 2; ++ai)
#pragma unroll
            for (int m = 0; m < 4; ++m) { bf16_t* rowp = O + (size_t)(row0 + ai * HALF + m * 16) * ldc + col0;
#pragma unroll
                for (int bj = 0; bj < 2; ++bj) store8(rowp + bj * HALF, acc[ai][bj][m][0], acc[ai][bj][m][1]); }
    }
};
struct EpiProjA {
    bf16_t *XR, *GG, *MQ; const float* rs;
    __device__ __forceinline__ void prefetch(float (&pre)[8], const Unit&, int, int) const {}
    __device__ __forceinline__ void operator()(const Acc& acc, const Unit& u, int wr, int wc, int fr_in, int fq_in, const float (&pre)[8]) const {
        int fr = fr_in, fq = fq_in; asm volatile("" : "+v"(fr), "+v"(fq));
        const int pn = u.pn; bf16_t* base; int ld, colt, mode;
        if (pn < 3) { base = XR; ld = LRU_W; colt = pn * 256; mode = 0; } else if (pn < 6) { base = GG; ld = LRU_W; colt = (pn - 3) * 256; mode = 1; } else { base = MQ; ld = MEM_W; colt = 0; mode = 2; }
        const int row0 = u.pm * BM + wr * 64 + fr, col0 = colt + wc * 32 + 8 * fq;
        float rloc[8];
#pragma unroll
        for (int q = 0; q < 8; ++q) rloc[q] = rs[row0 + (q >> 2) * HALF + (q & 3) * 16];
#pragma unroll
        for (int ai = 0; ai < 2; ++ai)
#pragma unroll
            for (int m = 0; m < 4; ++m) { bf16_t* rowp = base + (size_t)(row0 + ai * HALF + m * 16) * ld + col0; const float rsv = rloc[ai * 4 + m];
#pragma unroll
                for (int bj = 0; bj < 2; ++bj) { f32x4 v0 = acc[ai][bj][m][0] * rsv, v1 = acc[ai][bj][m][1] * rsv;
                    if (mode == 1) {
#pragma unroll
                        for (int j = 0; j < 4; ++j) { v0[j] = gelu_tanh(v0[j]); v1[j] = gelu_tanh(v1[j]); } }
                    else if (mode == 2) { v0 = v0 * QSCALE; v1 = v1 * QSCALE; }
                    store8(rowp + bj * HALF, v0, v1); } }
    }
};
struct EpiMkv {
    bf16_t *MK, *MVT;
    __device__ __forceinline__ void prefetch(float (&pre)[8], const Unit&, int, int) const {}
    __device__ __forceinline__ void operator()(const Acc& acc, const Unit& u, int wr, int wc, int fr_in, int fq_in, const float (&pre)[8]) const {
        int fr = fr_in, fq = fq_in; asm volatile("" : "+v"(fr), "+v"(fq));
        const int l = u.pn >> 1;
        if ((u.pn & 1) == 0) {
            bf16_t* O = MK + (size_t)l * TM * 256; const int row0 = u.pm * BM + wr * 64 + fr, col0 = wc * 32 + 8 * fq;
#pragma unroll
            for (int ai = 0; ai < 2; ++ai)
#pragma unroll
                for (int m = 0; m < 4; ++m) { bf16_t* rowp = O + (size_t)(row0 + ai * HALF + m * 16) * 256 + col0;
#pragma unroll
                    for (int bj = 0; bj < 2; ++bj) store8(rowp + bj * HALF, acc[ai][bj][m][0], acc[ai][bj][m][1]); }
        } else {
            bf16_t* O = MVT + (size_t)l * TM * 256 + (size_t)u.pm * 256 * 256;
#pragma unroll
            for (int ai = 0; ai < 2; ++ai)
#pragma unroll
                for (int m = 0; m < 4; ++m) { const int mi = ai * HALF + wr * 64 + m * 16 + fr;
#pragma unroll
                    for (int bj = 0; bj < 2; ++bj)
#pragma unroll
                        for (int n = 0; n < 2; ++n)
#pragma unroll
                            for (int j = 0; j < 4; ++j) { const int c = bj * HALF + wc * 32 + 8 * fq + 4 * n + j; O[(size_t)c * 256 + mi] = (bf16_t)(cvt_pk_bf16(acc[ai][bj][m][n][j], 0.f) & 0xffffu); } }
        }
    }
};
struct EpiSwiglu {
    bf16_t* O; const float* rs;
    __device__ __forceinline__ void prefetch(float (&pre)[8], const Unit& u, int wr, int fr) const {
#pragma unroll
        for (int q = 0; q < 8; ++q) pre[q] = rs[u.pm * BM + wr * 64 + fr + (q >> 2) * HALF + (q & 3) * 16]; }
    __device__ __forceinline__ void operator()(const Acc& acc, const Unit& u, int wr, int wc, int fr_in, int fq_in, const float (&pre)[8]) const {
        int fr = fr_in, fq = fq_in; asm volatile("" : "+v"(fr), "+v"(fq));
        const int row0 = u.pm * BM + wr * 64 + fr, col0 = u.pn * HALF + wc * 32 + 8 * fq;
#pragma unroll
        for (int ai = 0; ai < 2; ++ai)
#pragma unroll
            for (int m = 0; m < 4; ++m) { bf16_t* rowp = O + (size_t)(row0 + ai * HALF + m * 16) * DFF + col0; const float rsv = pre[ai * 4 + m];
                f32x4 o[2]; const float c1 = -rsv * LOG2E, c2 = rsv * rsv;
#pragma unroll
                for (int n = 0; n < 2; ++n) { const f32x4 g4 = acc[ai][0][m][n], u4 = acc[ai][1][m][n]; const f32x4 t4 = g4 * c1; f32x4 d4;
#pragma unroll
                    for (int j = 0; j < 4; ++j) d4[j] = ex2(t4[j]);
                    d4 = d4 + 1.0f; f32x4 q4;
#pragma unroll
                    for (int j = 0; j < 4; ++j) q4[j] = rcpf_(d4[j]);
                    o[n] = ((g4 * u4) * c2) * q4; }
                store8(rowp, o[0], o[1]); }
    }
};
struct EpiKvq {
    bf16_t *KS, *VST, *Q; const float* rope; const float* rs;
    __device__ __forceinline__ void prefetch(float (&pre)[8], const Unit&, int, int) const {}
    __device__ __forceinline__ void operator()(const Acc& acc, const Unit& u, int wr, int wc, int fr_in, int fq_in, const float (&pre)[8]) const {
        int fr = fr_in, fq = fq_in; asm volatile("" : "+v"(fr), "+v"(fq));
        const int pn = u.pn;
        if (pn == 1) {
#pragma unroll
            for (int ai = 0; ai < 2; ++ai)
#pragma unroll
                for (int m = 0; m < 4; ++m) { const int row = u.pm * BM + ai * HALF + wr * 64 + m * 16 + fr; const int b = row >> 12, s = row & (SEQ - 1); const float rsv = rs[row];
                    bf16_t* O = VST + (size_t)b * 256 * SEQ + s;
#pragma unroll
                    for (int bj = 0; bj < 2; ++bj)
#pragma unroll
                        for (int n = 0; n < 2; ++n)
#pragma unroll
                            for (int j = 0; j < 4; ++j) { const int c = bj * HALF + wc * 32 + 8 * fq + 4 * n + j; O[(size_t)c * SEQ] = (bf16_t)(cvt_pk_bf16(acc[ai][bj][m][n][j] * rsv, 0.f) & 0xffffu); }
                    __builtin_amdgcn_sched_barrier(0); }
            return;
        }
        bf16_t* base; int ld, colt; float sc; bool do_rope;
        if (pn == 0) { base = KS; ld = 256; colt = 0; sc = 1.f; do_rope = true; }
        else { base = Q; ld = 1024; colt = (pn - 2) * 256; sc = QSCALE; do_rope = (pn < 5); }
        const int row0 = u.pm * BM + wr * 64 + fr, col0 = colt + wc * 32 + 8 * fq;
        const bool rot_lane = do_rope && ((wc & 1) == 0) && (fq < 2);
        const float sgn = (fq == 0) ? -1.f : 1.f;
#pragma unroll
        for (int ai = 0; ai < 2; ++ai)
#pragma unroll
            for (int m = 0; m < 4; ++m) { const int row = row0 + ai * HALF + m * 16; bf16_t* rowp = base + (size_t)row * ld + col0;
                const float* rp = rope + (size_t)(row & (SEQ - 1)) * 16; const float rsc = rs[row] * sc;
#pragma unroll
                for (int n = 0; n < 2; ++n) { const f32x4 cs = *(const f32x4*)(rp + 4 * n), sn = *(const f32x4*)(rp + 8 + 4 * n);
#pragma unroll
                    for (int bj = 0; bj < 2; ++bj) { float v[4];
#pragma unroll
                        for (int j = 0; j < 4; ++j) { const float x = acc[ai][bj][m][n][j]; const float pr = __shfl_xor(x, 16);
                            float o = x; if (rot_lane) o = x * cs[j] + sgn * pr * sn[j];
                            v[j] = o * rsc; }
                        u32x2 w; w.x = cvt_pk_bf16(v[0], v[1]); w.y = cvt_pk_bf16(v[2], v[3]); *(u32x2*)(rowp + bj * HALF + 4 * n) = w; }
                    __builtin_amdgcn_sched_barrier(0); }
                }
    }
};
}

constexpr int KPITCH = 144;
__device__ __forceinline__ void load_q(bf16x8 (&qr)[4], const bf16_t* Qp, int ldq, int lane) {
#pragma unroll
    for (int d0 = 0; d0 < 4; ++d0) qr[d0] = *(const bf16x8*)(Qp + (size_t)(lane & 31) * ldq + d0 * 16 + (lane >> 5) * 8);
}
template <int NKB, bool SWA>
__device__ __forceinline__ void attn_task(bf16x8 (&qr)[4], const bf16_t* Qnext, int ldq, const LAS char* Kl, const LAS char* Vl, int vpitch, int key0,
                                          bf16_t* Op, int ldo, float sink2, bool has_prev, int ci0  , int lane) {
    const int r32 = lane & 31, hi = lane >> 5;
    f32x16 p[NKB];
#pragma unroll
    for (int kb = 0; kb < NKB; ++kb) {
        const LAS char* kp = Kl + (key0 + 32 * kb + r32) * KPITCH + hi * 16;
        const f32x16 z16 = {0.f, 0.f, 0.f, 0.f, 0.f, 0.f, 0.f, 0.f, 0.f, 0.f, 0.f, 0.f, 0.f, 0.f, 0.f, 0.f};
#pragma unroll
        for (int d0 = 0; d0 < 4; ++d0) { const bf16x8 a = *(const LAS bf16x8*)(kp + d0 * 32); p[kb] = __builtin_amdgcn_mfma_f32_32x32x16_bf16(a, qr[d0], d0 ? p[kb] : z16, 0, 0, 0); }
    }
    float m = -INFINITY;
    if (SWA) {
#pragma unroll
        for (int kb = 0; kb < NKB; ++kb)
#pragma unroll
            for (int r = 0; r < 16; ++r) { const int cr = (r & 3) + 8 * (r >> 2) + 4 * hi; const int rel = 32 * kb + cr - r32;
                const int kwin = ci0 + 32 * kb + cr;
                const bool ok = (rel >= 1) && (rel <= 128) && (has_prev || kwin >= 128);
                if (!ok) p[kb][r] = -INFINITY; m = fmaxf(m, p[kb][r]); }
    } else {
#pragma unroll
        for (int kb = 0; kb < NKB; ++kb)
#pragma unroll
            for (int r = 0; r < 16; ++r) m = fmaxf(m, p[kb][r]);
    }
    m = fmaxf(m, __shfl_xor(m, 32));
    if (SWA) m = fmaxf(m, sink2);
    float sum = 0.f;
#pragma unroll
    for (int kb = 0; kb < NKB; ++kb)
#pragma unroll
        for (int r = 0; r < 16; ++r) { const float e = ex2(p[kb][r] - m); p[kb][r] = e; sum += e; }
    sum += __shfl_xor(sum, 32);
    if (SWA) sum += ex2(sink2 - m);
    const float inv = 1.f / sum;
    f32x16 o[2]; const f32x16 zo16 = {0.f, 0.f, 0.f, 0.f, 0.f, 0.f, 0.f, 0.f, 0.f, 0.f, 0.f, 0.f, 0.f, 0.f, 0.f, 0.f};
#pragma unroll
    for (int kb = 0; kb < NKB; ++kb)
#pragma unroll
        for (int ks = 0; ks < 2; ++ks) {
            u32x4 pw; pw.x = cvt_pk_bf16(p[kb][8 * ks + 0], p[kb][8 * ks + 1]); pw.y = cvt_pk_bf16(p[kb][8 * ks + 2], p[kb][8 * ks + 3]);
            pw.z = cvt_pk_bf16(p[kb][8 * ks + 4], p[kb][8 * ks + 5]); pw.w = cvt_pk_bf16(p[kb][8 * ks + 6], p[kb][8 * ks + 7]);
            const bf16x8 pf = __builtin_bit_cast(bf16x8, pw);
            const int kbase = key0 + 32 * kb + 16 * ks + 4 * hi;
#pragma unroll
            for (int nb = 0; nb < 2; ++nb) { const LAS char* vp = Vl + (32 * nb + r32) * vpitch + kbase * 2;
                const s16x4 lo = *(const LAS s16x4*)vp, hh = *(const LAS s16x4*)(vp + 16);
                const bf16x8 vf = (bf16x8){lo[0], lo[1], lo[2], lo[3], hh[0], hh[1], hh[2], hh[3]};
                o[nb] = __builtin_amdgcn_mfma_f32_32x32x16_bf16(vf, pf, (kb | ks) ? o[nb] : zo16, 0, 0, 0); }
        }
#pragma unroll
    for (int d0 = 0; d0 < 4; ++d0) qr[d0] = *(const bf16x8*)(Qnext + (size_t)r32 * ldq + d0 * 16 + hi * 8);
    bf16_t* orow = Op + (size_t)r32 * ldo;
#pragma unroll
    for (int nb = 0; nb < 2; ++nb)
#pragma unroll
        for (int g4 = 0; g4 < 4; ++g4) { u32x2 w; w.x = cvt_pk_bf16(o[nb][4 * g4 + 0] * inv, o[nb][4 * g4 + 1] * inv); w.y = cvt_pk_bf16(o[nb][4 * g4 + 2] * inv, o[nb][4 * g4 + 3] * inv);
            *(u32x2*)(orow + 32 * nb + 8 * g4 + 4 * hi) = w; }
}

__device__ __forceinline__ void load_k_tile(LAS char* Kl, const bf16_t* src, int gp, int nrows, int zero_rows, int tid) {
    for (int c = tid; c < nrows * 8; c += 512) { const int r = c >> 3, ch = c & 7; u32x4 v = (u32x4){0u, 0u, 0u, 0u};
        if (r >= zero_rows) v = *(const u32x4*)(src + (ptrdiff_t)r * gp + ch * 8);
        *(LAS u32x4*)(Kl + r * KPITCH + ch * 16) = v; }
}
__device__ __forceinline__ void load_vt_tile(LAS char* Vl, int vpitch, const bf16_t* src, int gp, int nkeys, int zero_keys, int tid) {
    const int cpr = nkeys >> 3;
    for (int c = tid; c < 64 * cpr; c += 512) { const int d = c / cpr, ch = c - d * cpr; u32x4 v = (u32x4){0u, 0u, 0u, 0u};
        if (ch * 8 >= zero_keys) v = *(const u32x4*)(src + (ptrdiff_t)d * gp + ch * 8);
        LAS char* dst = Vl + d * vpitch + ch * 16; *(LAS u32x2*)dst = (u32x2){v.x, v.y}; *(LAS u32x2*)(dst + 8) = (u32x2){v.z, v.w}; }
}

__device__ __forceinline__ const bf16_t* mem_qptr(const bf16_t* Qb, int ldq, int qcol0, int unit, int wid) {
    const int b = unit >> 6, h = (unit >> 4) & 3, c = unit & 15; return Qb + ((size_t)b * SEQ + c * 256 + wid * 32) * ldq + qcol0 + h * 64; }
__device__ __forceinline__ void mem_attn_phase(LAS char* lds, const bf16_t* Qb, int ldq, int qcol0, const bf16_t* MK, const bf16_t* MVT, bf16_t* Y, int wg, int nwg) {
    const int tid = threadIdx.x, wid = tid >> 6, lane = tid & 63;
    LAS char* Kl = lds; LAS char* Vl = lds + 256 * KPITCH; constexpr int VP = 520; constexpr int NU = BATCH * 4 * 16;
    bf16x8 qr[4];
    if (wg < NU) load_q(qr, mem_qptr(Qb, ldq, qcol0, wg, wid), ldq, lane);
    for (int unit = wg; unit < NU; unit += nwg) {
        const int b = unit >> 6, h = (unit >> 4) & 3, c = unit & 15;
        load_k_tile(Kl, MK + (size_t)b * NMEM * 256 + h * 64, 256, 256, 0, tid);
        load_vt_tile(Vl, VP, MVT + ((size_t)b * 256 + h * 64) * 256, 256, 256, 0, tid);
        __syncthreads();
        const size_t row = (size_t)b * SEQ + c * 256 + wid * 32;
        const int nu = (unit + nwg < NU) ? unit + nwg : unit;
        attn_task<8, false>(qr, mem_qptr(Qb, ldq, qcol0, nu, wid), ldq, Kl, Vl, VP, 0, Y + row * 1024 + LRU_W + h * 64, 1024, 0.f, true, 0, lane);
        __syncthreads();
    }
}
__device__ __forceinline__ const bf16_t* swa_qptr(const bf16_t* Q, int unit, int task) {
    const int b = unit >> 6, np = (unit >> 2) & 15, kh = unit & 3; const int blk = task / 12, rem = task - blk * 12, g = rem >> 2, j = rem & 3;
    return Q + ((size_t)b * SEQ + (2 * np + blk) * 128 + j * 32) * 1024 + (kh * 3 + g) * 64; }
__device__ __forceinline__ void swa_phase(LAS char* lds, const bf16_t* Q, const bf16_t* KS, const bf16_t* VST, const float* sinks, bf16_t* Y, int wg, int nwg) {
    const int tid = threadIdx.x, wid = tid >> 6, lane = tid & 63;
    LAS char* Kl = lds; LAS char* Vl = lds + 384 * KPITCH; constexpr int VP = 776; constexpr int NU = BATCH * 16 * 4;
    bf16x8 qr[4];
    if (wg < NU) load_q(qr, swa_qptr(Q, wg, wid), 1024, lane);
    for (int unit = wg; unit < NU; unit += nwg) {
        const int b = unit >> 6, np = (unit >> 2) & 15, kh = unit & 3;
        const int s0 = (2 * np - 1) * 128;
        const int zk = (np == 0) ? 128 : 0;
        load_k_tile(Kl, KS + ((ptrdiff_t)b * SEQ + s0) * 256 + kh * 64, 256, 384, zk, tid);
        load_vt_tile(Vl, VP, VST + ((ptrdiff_t)b * 256 + kh * 64) * SEQ + s0, SEQ, 384, zk, tid);
        __syncthreads();
#pragma unroll 1
        for (int task = wid; task < 24; task += 8) {
            const int blk = task / 12, rem = task - blk * 12, g = rem >> 2, j = rem & 3;
            const int head = kh * 3 + g;
            const size_t row = (size_t)b * SEQ + (2 * np + blk) * 128 + j * 32;
            const float sink2 = sinks[head] * LOG2E;
            const bf16_t* qn = (task + 8 < 24) ? swa_qptr(Q, unit, task + 8) : swa_qptr(Q, (unit + nwg < NU) ? unit + nwg : unit, wid);
            attn_task<5, true>(qr, qn, 1024, Kl, Vl, VP, 128 * blk + 32 * j, Y + row * 1024 + head * 64, 1024, sink2, (2 * np + blk) > 0, 32 * j, lane);
        }
        __syncthreads();
    }
}

struct RowPair { f32x4 v[2][4]; u32x2 mw[2][4]; int rows[2]; };
template <bool IN_BF>
__device__ __forceinline__ void rp_load(RowPair& P, const void* hin_, const bf16_t* mixed, int row, int ngw, int nrows, int lane) {
    P.rows[0] = row; P.rows[1] = (row + ngw < nrows) ? row + ngw : row;
#pragma unroll
    for (int q = 0; q < 2; ++q) {
        if (IN_BF) { const u32x2* hr = (const u32x2*)((const bf16_t*)hin_ + (size_t)P.rows[q] * D) + lane;
#pragma unroll
            for (int j = 0; j < 4; ++j) { const u32x2 w = hr[64 * j]; P.v[q][j] = (f32x4){__uint_as_float(w.x), __uint_as_float(w.y), 0.f, 0.f}; } }
        else { const f32x4* hr = (const f32x4*)((const float*)hin_ + (size_t)P.rows[q] * D) + lane;
#pragma unroll
            for (int j = 0; j < 4; ++j) P.v[q][j] = hr[64 * j]; }
        if (mixed) { const u32x2* mr = (const u32x2*)(mixed + (size_t)P.rows[q] * D) + lane;
#pragma unroll
            for (int j = 0; j < 4; ++j) P.mw[q][j] = mr[64 * j]; }
    }
}
template <bool IN_BF, bool OUT_BF>
__device__ __forceinline__ void rp_proc(RowPair& P, const bf16_t* mixed, const float* g_post, void* hout_, const float* g_next, bf16_t* HNo, float* RSo, int lane) {
#pragma unroll
    for (int q = 0; q < 2; ++q) {
        f32x4 v[4];
#pragma unroll
        for (int j = 0; j < 4; ++j) { if (IN_BF) { const unsigned wx = __float_as_uint(P.v[q][j][0]), wy = __float_as_uint(P.v[q][j][1]); v[j] = (f32x4){bf_lo(wx), bf_hi(wx), bf_lo(wy), bf_hi(wy)}; } else v[j] = P.v[q][j]; }
        if (mixed) { f32x4 mv[4]; float s = 0.f;
#pragma unroll
            for (int j = 0; j < 4; ++j) { const u32x2 w = P.mw[q][j]; mv[j] = (f32x4){bf_lo(w.x), bf_hi(w.x), bf_lo(w.y), bf_hi(w.y)}; s += (mv[j][0] * mv[j][0] + mv[j][1] * mv[j][1]) + (mv[j][2] * mv[j][2] + mv[j][3] * mv[j][3]); }
            const float rstd = __builtin_amdgcn_rsqf(wave_sum(s) * (1.f / D) + EPS);
#pragma unroll
            for (int j = 0; j < 4; ++j) { const f32x4 gp = *((const f32x4*)g_post + lane + 64 * j); v[j] = v[j] + mv[j] * rstd * gp; } }
        if (hout_) {
            if (OUT_BF) { u32x2* ho = (u32x2*)((bf16_t*)hout_ + (size_t)P.rows[q] * D) + lane;
#pragma unroll
                for (int j = 0; j < 4; ++j) { u32x2 w; w.x = cvt_pk_bf16(v[j][0], v[j][1]); w.y = cvt_pk_bf16(v[j][2], v[j][3]); ho[64 * j] = w; } }
            else { f32x4* ho = (f32x4*)((float*)hout_ + (size_t)P.rows[q] * D) + lane;
#pragma unroll
                for (int j = 0; j < 4; ++j) ho[64 * j] = v[j]; } }
        if (HNo || RSo) { float s = 0.f;
#pragma unroll
            for (int j = 0; j < 4; ++j) s += (v[j][0] * v[j][0] + v[j][1] * v[j][1]) + (v[j][2] * v[j][2] + v[j][3] * v[j][3]);
            const float rstd = __builtin_amdgcn_rsqf(wave_sum(s) * (1.f / D) + EPS);
            if (RSo) { if (lane == 0) RSo[P.rows[q]] = rstd; }
            else { u32x2* o8 = (u32x2*)(HNo + (size_t)P.rows[q] * D) + lane;
#pragma unroll
                for (int j = 0; j < 4; ++j) { f32x4 gn = (f32x4){1.f, 1.f, 1.f, 1.f}; if (g_next) gn = *((const f32x4*)g_next + lane + 64 * j); const f32x4 o = v[j] * rstd * gn;
                    u32x2 w; w.x = cvt_pk_bf16(o[0], o[1]); w.y = cvt_pk_bf16(o[2], o[3]); o8[64 * j] = w; } } }
    }
}
template <bool IN_BF, bool OUT_BF>
__device__ __forceinline__ void norm_rows(const void* hin_, const bf16_t* mixed, const float* g_post, void* hout_, const float* g_next, bf16_t* HNo, float* RSo, int nrows, int gw, int ngw, int lane) {
    const int step = 2 * ngw;
    if (gw >= nrows) return;
    RowPair A, B;
    rp_load<IN_BF>(A, hin_, mixed, gw, ngw, nrows, lane);
    for (int row = gw; row < nrows; row += 2 * step) {
        const bool hasB = row + step < nrows, hasA2 = row + 2 * step < nrows;
        if (hasB) rp_load<IN_BF>(B, hin_, mixed, row + step, ngw, nrows, lane);
        rp_proc<IN_BF, OUT_BF>(A, mixed, g_post, hout_, g_next, HNo, RSo, lane);
        if (hasA2) rp_load<IN_BF>(A, hin_, mixed, row + 2 * step, ngw, nrows, lane);
        if (hasB) rp_proc<IN_BF, OUT_BF>(B, mixed, g_post, hout_, g_next, HNo, RSo, lane);
    }
}
__device__ __forceinline__ void tr_item(const float* W, int ldw, int k0, int n0, bf16_t* WT, int ldt, int dst_row0, const float* gk, LAS float* scr, int lane) {
    float wv[32];
#pragma unroll
    for (int i = 0; i < 32; ++i) { const int kk = 2 * i + (lane >> 5); wv[i] = W[(size_t)(k0 + kk) * ldw + n0 + (lane & 31)]; }
#pragma unroll
    for (int i = 0; i < 32; ++i) { const int kk = 2 * i + (lane >> 5); float w = wv[i]; if (gk) w *= gk[k0 + kk]; scr[kk * 33 + (lane & 31)] = w; }
    asm volatile("s_waitcnt lgkmcnt(0)" ::: "memory");
    const int c = lane & 7;
#pragma unroll
    for (int j = 0; j < 4; ++j) { const int n = (lane >> 3) + 8 * j; const LAS float* s = scr + (8 * c) * 33 + n;
        u32x4 o; o.x = cvt_pk_bf16(s[0 * 33], s[1 * 33]); o.y = cvt_pk_bf16(s[2 * 33], s[3 * 33]); o.z = cvt_pk_bf16(s[4 * 33], s[5 * 33]); o.w = cvt_pk_bf16(s[6 * 33], s[7 * 33]);
        *(u32x4*)(WT + (size_t)(dst_row0 + n) * ldt + k0 + 8 * c) = o; }
    asm volatile("s_waitcnt lgkmcnt(0)" ::: "memory");
}
__device__ __forceinline__ void sincos_d(double a, double& s, double& c) {
    const double k = __builtin_rint(a * 0.63661977236758134308);
    double r = __builtin_fma(-k, 1.57079632679489655800, a); r = __builtin_fma(-k, 6.123233995736766e-17, r);
    const double r2 = r * r;
    const double sp = r * (1.0 + r2 * (-1.0 / 6.0 + r2 * (1.0 / 120.0 + r2 * (-1.0 / 5040.0 + r2 * (1.0 / 362880.0 + r2 * (-1.0 / 39916800.0 + r2 * (1.0 / 6227020800.0)))))));
    const double cp = 1.0 + r2 * (-0.5 + r2 * (1.0 / 24.0 + r2 * (-1.0 / 720.0 + r2 * (1.0 / 40320.0 + r2 * (-1.0 / 3628800.0 + r2 * (1.0 / 479001600.0 + r2 * (-1.0 / 87178291200.0)))))));
    const int q = ((int)k) & 3;
    s = (q == 0) ? sp : (q == 1) ? cp : (q == 2) ? -sp : -cp;
    c = (q == 0) ? cp : (q == 1) ? -sp : (q == 2) ? -cp : sp;
}

struct Args { const float* in[23]; float* out; unsigned char* ws; int ph_lo, ph_hi, coop, pad; };
enum { I_X = 0, I_MEM, I_NMIXPRE, I_NMIXPOST, I_NFFNPRE, I_NFFNPOST, I_MEMNORM, I_WMEMKV, I_WINA, I_CONVW, I_CONVB, I_WGR, I_BGR, I_WGI, I_BGI, I_LAM, I_NKV, I_WKV, I_WINB, I_SINKS, I_WOUT, I_WFFI, I_WFFO };
constexpr int NPH = 17;

#define Wmkv ((bf16_t*)(args.ws + O_WMKV))
#define Wina ((bf16_t*)(args.ws + O_WINA))
#define Wg ((bf16_t*)(args.ws + O_WG))
#define Wkvq ((bf16_t*)(args.ws + O_WKVQ))
#define Wout ((bf16_t*)(args.ws + O_WOUT))
#define Wffi ((bf16_t*)(args.ws + O_WFFI))
#define Wffo ((bf16_t*)(args.ws + O_WFFO))
#define MEMN ((bf16_t*)(args.ws + O_MEMN))
#define MK ((bf16_t*)(args.ws + O_MK))
#define MVT ((bf16_t*)(args.ws + O_MVT))
#define HN ((bf16_t*)(args.ws + O_HN))
#define MIXED ((bf16_t*)(args.ws + O_MIXED))
#define KS ((bf16_t*)(args.ws + O_KS))
#define VST ((bf16_t*)(args.ws + O_VST))
#define XRLA ((bf16_t*)(args.ws + O_XRLA))
#define XC ((bf16_t*)(args.ws + O_XC))
#define GG ((bf16_t*)(args.ws + O_GG))
#define GATES ((bf16_t*)(args.ws + O_GATES))
#define MQ ((bf16_t*)(args.ws + O_MQ))
#define Y ((bf16_t*)(args.ws + O_Y))
#define Y1 ((bf16_t*)(args.ws + O_Y1))
#define HB ((bf16_t*)(args.ws + O_HB))
#define RS ((float*)(args.ws + O_RS))
#define Q ((bf16_t*)(args.ws + O_Q))
#define FF ((bf16_t*)(args.ws + O_FF))
#define rope ((float*)(args.ws + O_ROPE))
#define clam ((float*)(args.ws + O_CLAM))
#define H (args.out)
#define in (args.in)
#define XB_TMO      128
#define XB_XCNT(j)  (256  + 64 * (j))
#define XB_XSUB(j)  (1280 + 64 * (j))
#define XB_XGEN(j)  (2304 + 64 * (j))
#define XB_TOP      3328
#define XB_TOPGEN   3392
#define XCD_BAR_WORDS 3456
#define XB_SPIN_CAP (1u << 22)
__device__ __forceinline__ unsigned xb_ld(unsigned* p)              { return __hip_atomic_load(p, __ATOMIC_RELAXED, __HIP_MEMORY_SCOPE_AGENT); }
__device__ __forceinline__ unsigned xb_add(unsigned* p, unsigned v) { return __hip_atomic_fetch_add(p, v, __ATOMIC_RELAXED, __HIP_MEMORY_SCOPE_AGENT); }
__device__ __forceinline__ unsigned xb_xcc_id() { return (unsigned)__builtin_amdgcn_s_getreg((3 << 11) | 20) & 0xFu; }
#define XB_SPIN(cond, bar) do { unsigned _sp = 0; while (cond) { __builtin_amdgcn_s_sleep(1); \
    if ((++_sp & 255u) == 0u) { if (xb_ld(&(bar)[XB_TMO])) break; if (_sp > XB_SPIN_CAP) { atomicAdd(&(bar)[XB_TMO], 1u); break; } } } } while (0)
__device__ __forceinline__ void xcd_barrier_complete(unsigned* bar, unsigned x, unsigned& nloc, unsigned& nx) {
    const unsigned G = gridDim.x * gridDim.y * gridDim.z;
    unsigned sum, cnt, mine, sp = 0u;
    for (;;) {
        sum = 0u; cnt = 0u; mine = 0u;
#pragma unroll
        for (unsigned j = 0; j < 16; ++j) { const unsigned c = xb_ld(&bar[XB_XCNT(j)]); sum += c; cnt += (c > 0u) ? 1u : 0u; mine = (j == x) ? c : mine; }
        if (sum == G) break;
        __builtin_amdgcn_s_sleep(1);
        if ((++sp & 255u) == 0u) { if (xb_ld(&bar[XB_TMO])) break; if (sp > XB_SPIN_CAP) { atomicAdd(&bar[XB_TMO], 1u); break; } }
    }
    nloc = mine > 0u ? mine : 1u; nx = cnt > 0u ? cnt : 1u;
}
__device__ __forceinline__ void xcd_barrier(unsigned* bar, volatile LAS unsigned* st) {
    asm volatile("s_waitcnt vmcnt(0)" ::: "memory");
    __syncthreads();
    if (threadIdx.x == 0) {
        __builtin_amdgcn_s_waitcnt(0);
        const unsigned x = xb_xcc_id();
        unsigned nloc = st[0], nx = st[1];
        if (nloc == 0u) { xcd_barrier_complete(bar, x, nloc, nx); st[0] = nloc; st[1] = nx; }
        const unsigned old = xb_add(&bar[XB_XSUB(x)], 1u);
        const unsigned gen = old / nloc;
        if (old + 1u == (gen + 1u) * nloc) {
            __builtin_amdgcn_fence(__ATOMIC_RELEASE, "agent");
            asm volatile("s_waitcnt vmcnt(0)" ::: "memory");
            const unsigned og = xb_add(&bar[XB_TOP], 1u);
            const unsigned tg = og / nx;
            if (og + 1u == (tg + 1u) * nx) xb_add(&bar[XB_TOPGEN], 1u);
            else XB_SPIN(xb_ld(&bar[XB_TOPGEN]) == tg, bar);
            __builtin_amdgcn_fence(__ATOMIC_ACQUIRE, "agent");
            xb_add(&bar[XB_XGEN(x)], 1u);
            asm volatile("s_waitcnt vmcnt(0)" ::: "memory");
        } else {
            XB_SPIN(xb_ld(&bar[XB_XGEN(x)]) == gen, bar);
            __builtin_amdgcn_fence(__ATOMIC_ACQUIRE, "agent");
            asm volatile("s_waitcnt vmcnt(0)" ::: "memory");
        }
    }
    __syncthreads();
}
typedef const __attribute__((address_space(4))) Args* ArgsP;
__device__ __forceinline__ ArgsP get_args() { const unsigned long long a = (unsigned long long)__builtin_amdgcn_kernarg_segment_ptr(); unsigned lo32 = (unsigned)a, hi32 = (unsigned)(a >> 32);
    asm volatile("" : "+v"(lo32), "+v"(hi32)); lo32 = __builtin_amdgcn_readfirstlane(lo32); hi32 = __builtin_amdgcn_readfirstlane(hi32);
    return (ArgsP)(((unsigned long long)hi32 << 32) | lo32); }
#define args (*get_args())
__global__ void __launch_bounds__(512, 2) fwd_mega(Args args_by_value) {
    extern __shared__ __attribute__((aligned(16))) unsigned char lds_raw[];
    LAS unsigned char* lds = (LAS unsigned char*)lds_raw;
    const int G = gridDim.x, wg = blockIdx.x;
#define PHASE_IDS int tid = threadIdx.x; asm volatile("" : "+v"(tid)); const int lane = tid & 63, wave = __builtin_amdgcn_readfirstlane(tid >> 6); const int gw = wg * 8 + wave, ngw = G * 8; (void)lane; (void)gw; (void)ngw
    const int lo = args_by_value.ph_lo, hi = args_by_value.ph_hi, coop = args_by_value.coop;
#ifndef PHMASK
#define PHMASK 0x1FFFF
#endif
#ifndef DBL
#define DBL 0x0
#endif
#define NREP(k) ((((DBL) >> (k)) & 1) + 1)
#define IN(k) ((((PHMASK) >> (k)) & 1) && lo <= (k) && (k) < hi)
    if (coop == 2) cg::this_grid().sync();
    volatile LAS unsigned* xb_st = (volatile LAS unsigned*)(lds + LDS_BYTES - 64);
    if (coop) { if (threadIdx.x == 0) { xb_st[0] = 0u; xb_st[1] = 0u; (void)xb_add(&((unsigned*)args.ws)[XB_XCNT(xb_xcc_id())], 1u); } }
#define SYNC(k) do { if (coop && IN((k) + 1)) { xcd_barrier((unsigned*)args.ws, xb_st); } } while (0)

    if (IN(0)) for (int rep = 0; rep < NREP(0); ++rep) {
        PHASE_IDS;
        LAS float* scr = (LAS float*)(lds + wave * 16384);
        constexpr int I_MKV = 2 * 16 * 16, I_INA = 16 * 56, I_G = 12 * 2 * 4, I_KV = 16 * 16, I_INB = 16 * 32, I_OUT = 2 * 16 * 32, I_FFI = 2 * 16 * 176, I_FFO = 2 * 44 * 32;
        constexpr int NITEMS = I_MKV + I_INA + I_G + I_KV + I_INB + I_OUT + I_FFI + I_FFO;
        for (int it = gw; it < NITEMS; it += ngw) {
            int r = it;
            if (r < I_MKV) { const int l = r / 256, q = r % 256, kb = q / 16, nb = q % 16; tr_item(in[I_WMEMKV] + (size_t)l * 1024 * 512, 512, kb * 64, nb * 32, Wmkv, 1024, l * 512 + nb * 32, nullptr, scr, lane); continue; } r -= I_MKV;
            if (r < I_INA) { const int kb = r / 56, nb = r % 56; tr_item(in[I_WINA], A_IN, kb * 64, nb * 32, Wina, 1024, nb * 32, in[I_NMIXPRE], scr, lane); continue; } r -= I_INA;
            if (r < I_G) { const int mat = r / 8, q = r % 8, kb = q / 4, nb = q % 4; const int isI = mat / 6, h = mat % 6;
                tr_item((isI ? in[I_WGI] : in[I_WGR]) + (size_t)h * 128 * 128, 128, kb * 64, nb * 32, Wg + (size_t)h * 256 * 128, 128, isI * 128 + nb * 32, nullptr, scr, lane); continue; } r -= I_G;
            if (r < I_KV) { const int kb = r / 16, nb = r % 16; tr_item(in[I_WKV], 512, kb * 64, nb * 32, Wkvq, 1024, nb * 32, in[I_NKV], scr, lane); continue; } r -= I_KV;
            if (r < I_INB) { const int kb = r / 32, nb = r % 32; tr_item(in[I_WINB], 1024, kb * 64, nb * 32, Wkvq, 1024, 512 + nb * 32, in[I_NMIXPRE] + 1024, scr, lane); continue; } r -= I_INB;
            if (r < I_OUT) { const int l = r / 512, q = r % 512, kb = q / 32, nb = q % 32; tr_item(in[I_WOUT] + (size_t)l * 1024 * 1024, 1024, kb * 64, nb * 32, Wout + (size_t)l * 1024 * 1024, 1024, nb * 32, nullptr, scr, lane); continue; } r -= I_OUT;
            if (r < I_FFI) { const int l = r / 2816, q = r % 2816, kb = q / 176, nb = q % 176; const int c0 = nb * 32; const int isU = c0 >= DFF, f = c0 - isU * DFF;
                tr_item(in[I_WFFI] + (size_t)l * 1024 * 5632, 5632, kb * 64, c0, Wffi + (size_t)l * 5632 * 1024, 1024, (f / 128) * 256 + isU * 128 + (f % 128), in[I_NFFNPRE] + l * 1024, scr, lane); continue; } r -= I_FFI;
            { const int l = r / 1408, q = r % 1408, kb = q / 32, nb = q % 32; tr_item(in[I_WFFO] + (size_t)l * DFF * 1024, 1024, kb * 64, nb * 32, Wffo + (size_t)l * 1024 * DFF, DFF, nb * 32, nullptr, scr, lane); }
        }
        for (int e = wg * 512 + tid; e < SEQ * 8; e += G * 512) { const int s = e >> 3, i = e & 7;
            const double inv_freq[8] = {1.0, 0.19392274474868576, 0.03760603093086393, 0.007292664737217109, 0.001414213562373095, 0.0002742481756762073, 5.318295896944988e-05, 1.031338537721246e-05};
            double f = inv_freq[0];
#pragma unroll
            for (int q = 1; q < 8; ++q) f = (i == q) ? inv_freq[q] : f;
            double sn, cs; sincos_d((double)s * f, sn, cs); rope[s * 16 + i] = (float)cs; rope[s * 16 + 8 + i] = (float)sn; }
        for (int e = wg * 512 + tid; e < LRU_W; e += G * 512) { const float lam = in[I_LAM][e]; const float ls = fminf(lam, 0.f) - log1pf(expf(-fabsf(lam))); clam[e] = 8.f * ls * LOG2E; }
        norm_rows<false, false>(in[I_MEM], nullptr, nullptr, nullptr, in[I_MEMNORM], MEMN, nullptr, TM, gw, ngw, lane);
        norm_rows<false, true>(in[I_X], nullptr, nullptr, HB, nullptr, nullptr, RS, T, gw, ngw, lane);
    }
    SYNC(0);
    if (IN(1)) for (int rep = 0; rep < NREP(1); ++rep) {
        { pg8::Gemm g{MEMN, Wmkv, TM, 1024, 1024, 1024, 1024, 0}; pg8::StaticOrder S; S.init(TM, 1024, G, (wg + G / 2) % G); pg8::EpiMkv E{MK, MVT}; pg8::gemm_phase(lds, g, S, E); }
        { pg8::Gemm g{HB, Wina, T, A_IN, 1024, 1024, 1024, 0}; pg8::StaticOrder S; S.init(T, A_IN, G, wg); pg8::EpiProjA E{XRLA, GG, MQ, RS}; pg8::gemm_phase(lds, g, S, E); }
    }
    SYNC(1);
    if (IN(2)) for (int rep = 0; rep < NREP(2); ++rep) {
        PHASE_IDS;
        const float* cw = in[I_CONVW]; const float* cb = in[I_CONVB];
        for (int it = wg * 512 + tid; it < (T / 16) * 96; it += G * 512) {
            const int ch = (it % 96) * 8, rb = (it / 96) * 16;
            float w[4][8], bb[8];
#pragma unroll
            for (int k = 0; k < 4; ++k) { const f32x4 a = *(const f32x4*)(cw + k * LRU_W + ch), b2 = *(const f32x4*)(cw + k * LRU_W + ch + 4);
#pragma unroll
                for (int j = 0; j < 4; ++j) { w[k][j] = a[j]; w[k][4 + j] = b2[j]; } }
            { const f32x4 a = *(const f32x4*)(cb + ch), b2 = *(const f32x4*)(cb + ch + 4);
#pragma unroll
              for (int j = 0; j < 4; ++j) { bb[j] = a[j]; bb[4 + j] = b2[j]; } }
            float xw[4][8];
            const bool head = (rb & (SEQ - 1)) == 0;
#pragma unroll
            for (int q = 0; q < 3; ++q) { u32x4 v = (u32x4){0u, 0u, 0u, 0u}; if (!head) v = *(const u32x4*)(XRLA + (size_t)(rb - 3 + q) * LRU_W + ch);
#pragma unroll
                for (int j = 0; j < 4; ++j) { xw[q][2 * j] = bf_lo(v[j]); xw[q][2 * j + 1] = bf_hi(v[j]); } }
            u32x4 rowv[16];
#pragma unroll
            for (int rr = 0; rr < 16; ++rr) rowv[rr] = *(const u32x4*)(XRLA + (size_t)(rb + rr) * LRU_W + ch);
#pragma unroll
            for (int rr = 0; rr < 16; ++rr) {
                const u32x4 v = rowv[rr]; float o[8];
#pragma unroll
                for (int j = 0; j < 4; ++j) { xw[3][2 * j] = bf_lo(v[j]); xw[3][2 * j + 1] = bf_hi(v[j]); }
#pragma unroll
                for (int j = 0; j < 8; ++j) o[j] = bb[j] + w[0][j] * xw[0][j] + w[1][j] * xw[1][j] + w[2][j] * xw[2][j] + w[3][j] * xw[3][j];
                u32x4 ow; ow.x = cvt_pk_bf16(o[0], o[1]); ow.y = cvt_pk_bf16(o[2], o[3]); ow.z = cvt_pk_bf16(o[4], o[5]); ow.w = cvt_pk_bf16(o[6], o[7]);
                *(u32x4*)(XC + (size_t)(rb + rr) * LRU_W + ch) = ow;
#pragma unroll
                for (int j = 0; j < 8; ++j) { xw[0][j] = xw[1][j]; xw[1][j] = xw[2][j]; xw[2][j] = xw[3][j]; }
            }
        }
        if (G <= BATCH * 24) mem_attn_phase((LAS char*)lds, MQ, 256, 0, MK, MVT, Y, wg, G);
    }
    SYNC(2);
    if (IN(4)) for (int rep = 0; rep < NREP(4); ++rep) {
        PHASE_IDS;
        LAS char* Bl = (LAS char*)lds;
        LAS f32x2* sl = (LAS f32x2*)(lds + 64 * 272);
        const int n32 = lane & 31, hi = lane >> 5;
        const int tau = 16 * ((n32 >> 2) & 1) + (n32 & 3) + 4 * (n32 >> 3);
        if (G > BATCH * 24 && wg >= BATCH * 24) mem_attn_phase((LAS char*)lds, MQ, 256, 0, MK, MVT, Y, wg - BATCH * 24, G - BATCH * 24);
        for (int wgi = wg; wgi < BATCH * 24; wgi += G) {
            const int grp = (wgi & 7) + 8 * (wgi >> 5), q = (wgi >> 3) & 3;
            const int b = grp / 6, hb = grp % 6, c0 = q * 32, ch = hb * 128 + c0 + n32;
            __syncthreads();
            for (int c = tid; c < 64 * 16; c += 512) { const int row = c >> 4, kc = c & 15; const int wrow = (row < 32) ? (c0 + row) : (128 + c0 + row - 32);
                *(LAS u32x4*)(Bl + row * 272 + kc * 16) = *(const u32x4*)(Wg + ((size_t)hb * 256 + wrow) * 128 + kc * 8); }
            const float brv = in[I_BGR][ch], biv = in[I_BGI][ch], clv = clam[ch];
            __syncthreads();
            float hc = 0.f;
            LAS char* At = (LAS char*)lds + 64 * 272 + 16384 + wave * (32 * 272);
            const int lrow = lane >> 4, lcol = lane & 15;
            const bf16_t* xg_u = XC + ((size_t)b * SEQ + wave * 64 + lrow) * LRU_W + hb * 128 + lcol * 8;
            const bf16_t* gp_u = GG + ((size_t)b * SEQ + wave * 64 + 16 * hi) * LRU_W + ch;
            bf16_t* yp_u = Y + ((size_t)b * SEQ + wave * 64 + 16 * hi) * 1024 + ch;
            u32x4 st[2][8];
#pragma unroll
            for (int k = 0; k < 2; ++k)
#pragma unroll
                for (int i = 0; i < 8; ++i) st[k][i] = *(const u32x4*)(xg_u + (size_t)(k * 32 + i * 4) * LRU_W);
            for (int chunk = 0; chunk < 8; ++chunk) {
                float av[2][16], uv[2][16]; unsigned short gr[2][16];
                LAS f32x2* buf = sl + (chunk & 1) * 1024;
                const int cn = (chunk + 1 < 8) ? chunk + 1 : chunk;
#pragma unroll
                for (int k = 0; k < 2; ++k) {
#pragma unroll
                    for (int i = 0; i < 8; ++i) *(LAS u32x4*)(At + (i * 4 + lrow) * 272 + lcol * 16) = st[k][i];
#pragma unroll
                    for (int i = 0; i < 8; ++i) st[k][i] = *(const u32x4*)(xg_u + (size_t)(cn * 512 + k * 32 + i * 4) * LRU_W);
                    asm volatile("s_waitcnt lgkmcnt(0)" ::: "memory");
                    f32x16 accr, acci; const f32x16 z16 = {0.f, 0.f, 0.f, 0.f, 0.f, 0.f, 0.f, 0.f, 0.f, 0.f, 0.f, 0.f, 0.f, 0.f, 0.f, 0.f};
#pragma unroll
                    for (int ks = 0; ks < 8; ++ks) {
                        const bf16x8 afr = *(const LAS bf16x8*)(At + tau * 272 + ks * 32 + hi * 16);
                        const bf16x8 bfr = *(const LAS bf16x8*)(Bl + n32 * 272 + ks * 32 + hi * 16), bfi = *(const LAS bf16x8*)(Bl + (32 + n32) * 272 + ks * 32 + hi * 16);
                        accr = __builtin_amdgcn_mfma_f32_32x32x16_bf16(afr, bfr, ks ? accr : z16, 0, 0, 0);
                        acci = __builtin_amdgcn_mfma_f32_32x32x16_bf16(afr, bfi, ks ? acci : z16, 0, 0, 0);
                    }
                    float P = 1.f, L = 0.f;
#pragma unroll
                    for (int r = 0; r < 16; ++r) {
                        const unsigned short xs = *(const LAS unsigned short*)(At + (16 * hi + r) * 272 + (c0 + n32) * 2);
                        const float rr = sigmoidf_(accr[r] + brv), ii = sigmoidf_(acci[r] + biv);
                        const float a = ex2(rr * clv); float mlt = __builtin_sqrtf(1.f - a * a);
                        if (r == 0 && hi == 0 && k == 0 && chunk == 0 && wave == 0) mlt = 1.f;
                        const float u = mlt * ii * bf_lo((unsigned)xs);
                        av[k][r] = a; uv[k][r] = u;
                        L = a * L + u; P *= a;
                    }
                    buf[(wave * 4 + k * 2 + hi) * 32 + n32] = (f32x2){P, L};
                    asm volatile("s_waitcnt lgkmcnt(0)" ::: "memory");
                }
                __syncthreads();
#pragma unroll
                for (int k = 0; k < 2; ++k)
#pragma unroll
                    for (int r = 0; r < 16; ++r) gr[k][r] = gp_u[(size_t)(chunk * 512 + k * 32 + r) * LRU_W];
                float h = hc, hin0 = 0.f, hin1 = 0.f; const int sg0 = wave * 4 + hi, sg1 = sg0 + 2;
#pragma unroll 8
                for (int s2 = 0; s2 < 32; ++s2) { if (s2 == sg0) hin0 = h; if (s2 == sg1) hin1 = h; const f32x2 e0 = buf[s2 * 32 + n32]; h = e0.x * h + e0.y; }
                hc = h;
#pragma unroll
                for (int k = 0; k < 2; ++k) {
                    float hh = k ? hin1 : hin0;
                    bf16_t* yp = yp_u + (size_t)(chunk * 512 + k * 32) * 1024;
#pragma unroll
                    for (int r = 0; r < 16; ++r) { hh = av[k][r] * hh + uv[k][r]; yp[(size_t)r * 1024] = (bf16_t)(cvt_pk_bf16(hh * bf_lo((unsigned)gr[k][r]), 0.f) & 0xffffu); }
                }
            }
        }
    }
    SYNC(4);
    if (IN(5)) for (int rep = 0; rep < NREP(5); ++rep) { pg8::Gemm g{Y, Wout, T, 1024, 1024, 1024, 1024, 0}; pg8::StaticOrder S; S.init(T, 1024, G, wg); pg8::EpiPlain E{MIXED, 1024}; pg8::gemm_phase(lds, g, S, E); }
    SYNC(5);
    if (IN(6)) for (int rep = 0; rep < NREP(6); ++rep) { PHASE_IDS; norm_rows<true, true>(HB, MIXED, in[I_NMIXPOST], HB, nullptr, nullptr, RS, T, gw, ngw, lane); }
    SYNC(6);
    if (IN(7)) for (int rep = 0; rep < NREP(7); ++rep) { pg8::Gemm g{HB, Wffi, T, 5632, 1024, 1024, 1024, 0}; pg8::StaticOrder S; S.init(T, 5632, G, wg); pg8::EpiSwiglu E{FF, RS}; pg8::gemm_phase(lds, g, S, E); }
    SYNC(7);
    if (IN(8)) for (int rep = 0; rep < NREP(8); ++rep) { pg8::Gemm g{FF, Wffo, T, 1024, DFF, DFF, DFF, 0}; pg8::StaticOrder S; S.init(T, 1024, G, wg); pg8::EpiPlain E{MIXED, 1024}; pg8::gemm_phase(lds, g, S, E); }
    SYNC(8);
    if (IN(9)) for (int rep = 0; rep < NREP(9); ++rep) { PHASE_IDS; norm_rows<true, true>(HB, MIXED, in[I_NFFNPOST], HB, nullptr, nullptr, RS, T, gw, ngw, lane); }
    SYNC(9);
    if (IN(10)) for (int rep = 0; rep < NREP(10); ++rep) { pg8::Gemm g{HB, Wkvq, T, 1536, 1024, 1024, 1024, 0}; pg8::StaticOrder S; S.init(T, 1536, G, wg); pg8::EpiKvq E{KS, VST, Q, rope, RS}; pg8::gemm_phase(lds, g, S, E); }
    SYNC(10);
    if (IN(11)) for (int rep = 0; rep < NREP(11); ++rep) {
        swa_phase((LAS char*)lds, Q, KS, VST, in[I_SINKS], Y1, wg, G);
        mem_attn_phase((LAS char*)lds, Q, 1024, LRU_W, MK + (size_t)TM * 256, MVT + (size_t)TM * 256, Y1, wg, G);
    }
    SYNC(11);
    if (IN(12)) for (int rep = 0; rep < NREP(12); ++rep) { pg8::Gemm g{Y1, Wout + (size_t)1024 * 1024, T, 1024, 1024, 1024, 1024, 0}; pg8::StaticOrder S; S.init(T, 1024, G, wg); pg8::EpiPlain E{MIXED, 1024}; pg8::gemm_phase(lds, g, S, E); }
    SYNC(12);
    if (IN(13)) for (int rep = 0; rep < NREP(13); ++rep) { PHASE_IDS; norm_rows<true, true>(HB, MIXED, in[I_NMIXPOST] + 1024, HB, nullptr, nullptr, RS, T, gw, ngw, lane); }
    SYNC(13);
    if (IN(14)) for (int rep = 0; rep < NREP(14); ++rep) { pg8::Gemm g{HB, Wffi + (size_t)5632 * 1024, T, 5632, 1024, 1024, 1024, 0}; pg8::StaticOrder S; S.init(T, 5632, G, wg); pg8::EpiSwiglu E{FF, RS}; pg8::gemm_phase(lds, g, S, E); }
    SYNC(14);
    if (IN(15)) for (int rep = 0; rep < NREP(15); ++rep) { pg8::Gemm g{FF, Wffo + (size_t)1024 * DFF, T, 1024, DFF, DFF, DFF, 0}; pg8::StaticOrder S; S.init(T, 1024, G, wg); pg8::EpiPlain E{MIXED, 1024}; pg8::gemm_phase(lds, g, S, E); }
    SYNC(15);
    if (IN(16)) for (int rep = 0; rep < NREP(16); ++rep) { PHASE_IDS; norm_rows<true, false>(HB, MIXED, in[I_NFFNPOST] + 1024, H, nullptr, nullptr, nullptr, T, gw, ngw, lane); }
#undef IN
#undef SYNC
}

#undef args
#undef Wmkv
#undef Wina
#undef Wg
#undef Wkvq
#undef Wout
#undef Wffi
#undef Wffo
#undef MEMN
#undef MK
#undef MVT
#undef HN
#undef MIXED
#undef KS
#undef VST
#undef XRLA
#undef XC
#undef GG
#undef GATES
#undef MQ
#undef Y
#undef Y1
#undef HB
#undef RS
#undef Q
#undef FF
#undef rope
#undef clam
#undef H
#undef in
extern "C" void kernel_launch(void* const* d_in, const int* in_sizes, int n_in, void* d_out, int out_size, void* d_ws, size_t ws_size, hipStream_t stream) {
    static int grid = 0;
    if (grid == 0) {
        if (n_in != 23 || in_sizes[0] != T * D || out_size != T * D || ws_size < WS_NEED) { fprintf(stderr, "kernel_launch: unexpected shapes (n_in %d, in0 %d, out %d, ws %zu < %zu)\n", n_in, n_in > 0 ? in_sizes[0] : -1, out_size, ws_size, (size_t)WS_NEED); grid = -1; return; }
        int dev = 0, cus = 0, per_cu = 0;
        (void)hipGetDevice(&dev); (void)hipDeviceGetAttribute(&cus, hipDeviceAttributeMultiprocessorCount, dev);
        if (hipFuncSetAttribute((const void*)fwd_mega, hipFuncAttributeMaxDynamicSharedMemorySize, LDS_BYTES) != hipSuccess) { fprintf(stderr, "kernel_launch: hipFuncSetAttribute failed\n"); grid = -1; return; }
        if (hipOccupancyMaxActiveBlocksPerMultiprocessor(&per_cu, (const void*)fwd_mega, 512, LDS_BYTES) != hipSuccess || per_cu < 1) { fprintf(stderr, "kernel_launch: occupancy query says %d\n", per_cu); per_cu = 1; }
        (void)hipGetLastError();
        grid = cus * per_cu;
        fprintf(stderr, "kernel_launch: grid %d (cus %d x %d)\n", grid, cus, per_cu);
    }
    if (grid < 0) return;
    if (hipMemsetAsync(d_ws, 0, 65536, stream) != hipSuccess) { fprintf(stderr, "kernel_launch: memset failed\n"); return; }
    Args a{};
    for (int i = 0; i < 23; ++i) a.in[i] = (const float*)d_in[i];
    a.out = (float*)d_out; a.ws = (unsigned char*)d_ws; a.pad = 0;
#if MK_MULTI
    for (int ph = 0; ph < NPH; ++ph) { a.ph_lo = ph; a.ph_hi = ph + 1; a.coop = 0; hipLaunchKernelGGL(fwd_mega, dim3(grid), dim3(512), LDS_BYTES, stream, a); }
#else
    a.ph_lo = 0; a.ph_hi = NPH; a.coop = 1;
    void* kargs[] = {&a};
    hipError_t e = hipLaunchCooperativeKernel((const void*)fwd_mega, dim3(grid), dim3(512), kargs, LDS_BYTES, stream);
    if (e != hipSuccess) fprintf(stderr, "kernel_launch: cooperative launch failed: %s (grid %d)\n", hipGetErrorString(e), grid);
#endif
}
```
